# Optimizing an MI355X kernel written in HIP

```python
import math
import jax, jax.numpy as jnp
from jax import lax
import numpy as np

D_MODEL = 2048
BATCH = 4
SEQ = 8192
DEPTH = 1

PLE_DIM = 256
MIX_WIDTH = D_MODEL
ATTN_WIDTH = MIX_WIDTH // 2
HEAD_DIM = 64
N_HEADS = ATTN_WIDTH // HEAD_DIM
SSM_WIDTH = MIX_WIDTH - ATTN_WIDTH
SSM_GROUP = 16
N_SSM_GROUPS = SSM_WIDTH // SSM_GROUP
SSM_STATE = 64
D_FF = ((8 * D_MODEL // 3 + 127) // 128) * 128
DILATIONS = ((128, 1), (512, 4), (2048, 16))
SWA_BLOCK = 128
NORM_EPS = 1e-6
DT_MIN = 1e-3
DT_MAX = 1e-1
MASK_VALUE = -1e30

kernel_name = 'hymba_dilated_s5_macaron'


def rms_norm(x, g):
    xf = x.astype(jnp.float32)
    y = xf * lax.rsqrt(jnp.mean(xf * xf, axis=-1, keepdims=True) + NORM_EPS)
    return (y * g.astype(jnp.float32)).astype(x.dtype)


def swiglu(x, w_gate, w_up, w_down):
    return (jax.nn.silu(x @ w_gate) * (x @ w_up)) @ w_down


def banded_attention_stats(q, k, v, span):
    N, H, L, E = q.shape
    Q = SWA_BLOCK
    nb = -(-L // Q)
    Lp = nb * Q
    qf, kf, vf = (t.astype(jnp.float32) for t in (q, k, v))
    qb = jnp.pad(qf, ((0, 0), (0, 0), (0, Lp - L), (0, 0))).reshape(N, H, nb, Q, E)
    kp = jnp.pad(kf, ((0, 0), (0, 0), (Q, Lp - L), (0, 0)))
    vp = jnp.pad(vf, ((0, 0), (0, 0), (Q, Lp - L), (0, 0)))
    kb = jnp.concatenate([kp[:, :, :Lp].reshape(N, H, nb, Q, E), kp[:, :, Q:].reshape(N, H, nb, Q, E)], axis=3)
    vb = jnp.concatenate([vp[:, :, :Lp].reshape(N, H, nb, Q, E), vp[:, :, Q:].reshape(N, H, nb, Q, E)], axis=3)
    s = jnp.einsum('nhbqe,nhbke->nhbqk', qb, kb) * (E ** -0.5)
    qi = jnp.arange(Q)[:, None]
    ki = jnp.arange(2 * Q)[None, :]
    dist = qi + Q - ki
    blk = jnp.arange(nb)[:, None, None]
    valid = (dist >= 0) & (dist <= span) & (blk * Q + ki - Q >= 0)
    s = jnp.where(valid, s, MASK_VALUE)
    m = jnp.max(s, axis=-1)
    pexp = jnp.exp(s - m[..., None])
    l = jnp.sum(pexp, axis=-1)
    o = jnp.einsum('nhbqk,nhbke->nhbqe', pexp, vb)
    o = o.reshape(N, H, Lp, E)[:, :, :L]
    m = m.reshape(N, H, Lp)[:, :, :L]
    l = l.reshape(N, H, Lp)[:, :, :L]
    return o, m, l


def dilated_attention(q, k, v):
    B, S, H, E = q.shape
    outs, maxes, dens = [], [], []
    for window, d in DILATIONS:
        L = S // d
        span = window // d

        def to_residue(t):
            return t.reshape(B, L, d, H, E).transpose(0, 2, 3, 1, 4).reshape(B * d, H, L, E)

        o, m, l = banded_attention_stats(to_residue(q), to_residue(k), to_residue(v), span)
        outs.append(o.reshape(B, d, H, L, E).transpose(0, 3, 1, 2, 4).reshape(B, S, H, E))
        maxes.append(m.reshape(B, d, H, L).transpose(0, 3, 1, 2).reshape(B, S, H))
        dens.append(l.reshape(B, d, H, L).transpose(0, 3, 1, 2).reshape(B, S, H))
    m_all = jnp.stack(maxes, axis=0)
    m_glob = jnp.max(m_all, axis=0)
    w = jnp.exp(m_all - m_glob[None])
    num = sum(w[i][..., None] * outs[i] for i in range(len(DILATIONS)))
    den = sum(w[i] * dens[i] for i in range(len(DILATIONS)))
    return (num / den[..., None]).astype(q.dtype)


def _ssm_combine(left, right):
    ar_l, ai_l, br_l, bi_l = left
    ar_r, ai_r, br_r, bi_r = right
    return (ar_r * ar_l - ai_r * ai_l,
            ar_r * ai_l + ai_r * ar_l,
            ar_r * br_l - ai_r * bi_l + br_r,
            ar_r * bi_l + ai_r * br_l + bi_r)


def s5_mixer(u, lam_re, lam_im, log_dt, b_re, b_im, c_re, c_im, d_skip, w_glu, b_glu):
    B, S, _ = u.shape
    G, P, C = N_SSM_GROUPS, SSM_STATE, SSM_GROUP
    uf = u.astype(jnp.float32).reshape(B, S, G, C)
    lr = lam_re.astype(jnp.float32)
    li = lam_im.astype(jnp.float32)
    dt = jnp.exp(log_dt.astype(jnp.float32))[:, None]
    mag = jnp.exp(lr * dt)
    ar = mag * jnp.cos(li * dt)
    ai = mag * jnp.sin(li * dt)
    nr, ni = ar - 1.0, ai
    den = lr * lr + li * li
    cr = (nr * lr + ni * li) / den
    ci = (ni * lr - nr * li) / den
    br, bi = b_re.astype(jnp.float32), b_im.astype(jnp.float32)
    bbr = cr[..., None] * br - ci[..., None] * bi
    bbi = cr[..., None] * bi + ci[..., None] * br
    xr = jnp.einsum('gpc,bsgc->bsgp', bbr, uf)
    xi = jnp.einsum('gpc,bsgc->bsgp', bbi, uf)
    a_r = jnp.broadcast_to(ar[None, None], (1, S, G, P))
    a_i = jnp.broadcast_to(ai[None, None], (1, S, G, P))
    _, _, hr, hi = lax.associative_scan(_ssm_combine, (a_r, a_i, xr, xi), axis=1)
    y = (jnp.einsum('gcp,bsgp->bsgc', c_re.astype(jnp.float32), hr)
         - jnp.einsum('gcp,bsgp->bsgc', c_im.astype(jnp.float32), hi)
         + d_skip.astype(jnp.float32).reshape(G, C) * uf)
    y = jax.nn.gelu(y.reshape(B, S, SSM_WIDTH)).astype(u.dtype)
    return y * jax.nn.sigmoid(y @ w_glu + b_glu)


def setup_inputs(seed: int = 0) -> dict:
    key = jax.random.key(seed)
    ks = iter(jax.random.split(key, 40))

    def nrm(shape, scale):
        return jax.random.normal(next(ks), shape, jnp.float32) * scale

    def gain(shape):
        return 1.0 + nrm(shape, 0.02)

    L_ = DEPTH
    G, P, C = N_SSM_GROUPS, SSM_STATE, SSM_GROUP
    return {
        'x': nrm((BATCH, SEQ, D_MODEL), 1.0),
        'p': nrm((DEPTH, BATCH, SEQ, PLE_DIM), 1.0),
        'ffn1_norm': gain((L_, D_MODEL)),
        'ffn1_w_gate': nrm((L_, D_MODEL, D_FF), D_MODEL ** -0.5),
        'ffn1_w_up': nrm((L_, D_MODEL, D_FF), D_MODEL ** -0.5),
        'ffn1_w_down': nrm((L_, D_FF, D_MODEL), D_FF ** -0.5),
        'mix_norm': gain((L_, D_MODEL)),
        'w_in': nrm((L_, D_MODEL, 3 * ATTN_WIDTH + SSM_WIDTH), D_MODEL ** -0.5),
        'attn_out_norm': gain((L_, ATTN_WIDTH)),
        'ssm_lambda_re': -0.5 + nrm((L_, G, P), 0.01),
        'ssm_lambda_im': math.pi * jnp.arange(P, dtype=jnp.float32)[None, None, :] + nrm((L_, G, P), 0.01),
        'ssm_log_dt': jax.random.uniform(next(ks), (L_, G), jnp.float32, math.log(DT_MIN), math.log(DT_MAX)),
        'ssm_b_re': nrm((L_, G, P, C), (2.0 * C) ** -0.5),
        'ssm_b_im': nrm((L_, G, P, C), (2.0 * C) ** -0.5),
        'ssm_c_re': nrm((L_, G, C, P), (2.0 * P) ** -0.5),
        'ssm_c_im': nrm((L_, G, C, P), (2.0 * P) ** -0.5),
        'ssm_d': nrm((L_, SSM_WIDTH), 1.0),
        'ssm_w_glu': nrm((L_, SSM_WIDTH, SSM_WIDTH), SSM_WIDTH ** -0.5),
        'ssm_b_glu': nrm((L_, SSM_WIDTH), 0.01),
        'ssm_out_norm': gain((L_, SSM_WIDTH)),
        'w_out': nrm((L_, MIX_WIDTH, D_MODEL), MIX_WIDTH ** -0.5),
        'ffn2_norm': gain((L_, D_MODEL)),
        'ffn2_w_gate': nrm((L_, D_MODEL, D_FF), D_MODEL ** -0.5),
        'ffn2_w_up': nrm((L_, D_MODEL, D_FF), D_MODEL ** -0.5),
        'ffn2_w_down': nrm((L_, D_FF, D_MODEL), D_FF ** -0.5),
        'ple_norm': gain((L_, D_MODEL)),
        'ple_w_gate': nrm((L_, D_MODEL, D_MODEL), D_MODEL ** -0.5),
        'ple_w_proj': nrm((L_, PLE_DIM, D_MODEL), PLE_DIM ** -0.5),
        'final_norm': gain((D_MODEL,)),
    }


def reference(x, p, ffn1_norm, ffn1_w_gate, ffn1_w_up, ffn1_w_down, mix_norm, w_in,
              attn_out_norm, ssm_lambda_re, ssm_lambda_im, ssm_log_dt, ssm_b_re, ssm_b_im,
              ssm_c_re, ssm_c_im, ssm_d, ssm_w_glu, ssm_b_glu, ssm_out_norm, w_out,
              ffn2_norm, ffn2_w_gate, ffn2_w_up, ffn2_w_down, ple_norm, ple_w_gate,
              ple_w_proj, final_norm):
    B, S, _ = x.shape
    h = x
    for i in range(DEPTH):
        h = h + 0.5 * swiglu(rms_norm(h, ffn1_norm[i]), ffn1_w_gate[i], ffn1_w_up[i], ffn1_w_down[i])
        u = rms_norm(h, mix_norm[i])
        z = u @ w_in[i]
        q = z[..., :ATTN_WIDTH].reshape(B, S, N_HEADS, HEAD_DIM)
        k = z[..., ATTN_WIDTH:2 * ATTN_WIDTH].reshape(B, S, N_HEADS, HEAD_DIM)
        v = z[..., 2 * ATTN_WIDTH:3 * ATTN_WIDTH].reshape(B, S, N_HEADS, HEAD_DIM)
        s_in = z[..., 3 * ATTN_WIDTH:]
        ya = dilated_attention(q, k, v).reshape(B, S, ATTN_WIDTH)
        yb = s5_mixer(s_in, ssm_lambda_re[i], ssm_lambda_im[i], ssm_log_dt[i], ssm_b_re[i], ssm_b_im[i],
                      ssm_c_re[i], ssm_c_im[i], ssm_d[i], ssm_w_glu[i], ssm_b_glu[i])
        y = jnp.concatenate([rms_norm(ya, attn_out_norm[i]), rms_norm(yb, ssm_out_norm[i])], axis=-1)
        h = h + y @ w_out[i]
        h = h + 0.5 * swiglu(rms_norm(h, ffn2_norm[i]), ffn2_w_gate[i], ffn2_w_up[i], ffn2_w_down[i])
        gate = jax.nn.sigmoid(rms_norm(h, ple_norm[i]) @ ple_w_gate[i])
        h = h + gate * (p[i] @ ple_w_proj[i])
    return rms_norm(h, final_norm)
```

```cpp
#include <hip/hip_runtime.h>
#include <hip/hip_cooperative_groups.h>
#include <cstdio>
#include <cstdint>
namespace cg = cooperative_groups;

#define LAS __attribute__((address_space(3)))
typedef unsigned short bf16_t;
typedef short bf16x8 __attribute__((ext_vector_type(8)));
typedef short s16x4 __attribute__((ext_vector_type(4)));
typedef float f32x4 __attribute__((ext_vector_type(4)));
typedef float f32x2 __attribute__((ext_vector_type(2)));
typedef float f32x16 __attribute__((ext_vector_type(16)));
typedef unsigned u32x4 __attribute__((ext_vector_type(4)));
typedef unsigned u32x2 __attribute__((ext_vector_type(2)));

constexpr int SEQ = 8192, DM = 2048, MT = 32768, FF = 5504, NGU = 2 * FF, NIN = 4096, AW = 1024, SW = 1024, PLE = 256;
constexpr int SG = 64, SP = 64, SC = 16, LC = 16, NCH = SEQ / LC, ROWS_G = 4 * NCH  , KT = 384;
constexpr float EPS = 1e-6f;

constexpr size_t MiB = 1u << 20;
constexpr size_t al(size_t x) { return (x + MiB - 1) / MiB * MiB; }
constexpr size_t WS_GU1 = 0;
constexpr size_t WS_DN1 = WS_GU1 + al((size_t)NGU * DM * 2);
constexpr size_t WS_GU2 = WS_DN1 + al((size_t)DM * FF * 2);
constexpr size_t WS_DN2 = WS_GU2 + al((size_t)NGU * DM * 2);
constexpr size_t WS_WIN = WS_DN2 + al((size_t)DM * FF * 2);
constexpr size_t WS_WOUT = WS_WIN + al((size_t)NIN * DM * 2);
constexpr size_t WS_WPG = WS_WOUT + al((size_t)DM * DM * 2);
constexpr size_t WS_WPLE = WS_WPG + al((size_t)DM * DM * 2);
constexpr size_t WS_WGLU = WS_WPLE + al((size_t)DM * PLE * 2);
constexpr size_t WS_TG = WS_WGLU + al((size_t)SW * SW * 2);
constexpr size_t WS_EB = WS_TG + al((size_t)SG * 256 * KT * 2);
constexpr size_t WS_PBF = WS_EB + al((size_t)SG * 256 * 256 * 2);
constexpr size_t WS_A16 = WS_PBF + al((size_t)MT * PLE * 2);
constexpr size_t WS_BAR = WS_A16 + 65536;
constexpr size_t WS_SS = WS_A16 + 131072;
constexpr size_t WS_U = WS_A16 + MiB;
constexpr size_t WS_BIG = WS_U + al((size_t)MT * DM * 2);
constexpr size_t WS_HID = WS_BIG;
constexpr size_t WS_QKV = WS_BIG;
constexpr size_t WS_ASSM = WS_QKV + al((size_t)MT * 3072 * 2);
constexpr size_t WS_E = WS_ASSM + al((size_t)SG * ROWS_G * KT * 2);
constexpr size_t WS_OP = WS_E + al((size_t)SG * ROWS_G * 128 * 4);
constexpr size_t WS_ML = WS_OP + al((size_t)3 * MT * AW * 2);
constexpr size_t WS_MIXEND = WS_ML + al((size_t)3 * MT * 16 * 2 * 4);
constexpr size_t WS_Y = WS_BIG;
constexpr size_t WS_PP = WS_BIG + 384 * MiB;
constexpr size_t WS_END = (WS_MIXEND > WS_HID + al((size_t)MT * FF * 2)) ? WS_MIXEND : WS_HID + al((size_t)MT * FF * 2);
static_assert(WS_END <= (size_t)1024 * MiB && WS_PP >= WS_HID + (size_t)MT * FF * 2 && WS_PP + (size_t)MT * DM * 2 <= WS_END && WS_SS + 3 * MT * 4 <= WS_U, "workspace map");

constexpr int LDS_BYTES = 147456;

__device__ __forceinline__ unsigned f2bf(float f) { unsigned u = __builtin_bit_cast(unsigned, f); return (u + 0x7fffu + ((u >> 16) & 1u)) >> 16; }
__device__ __forceinline__ unsigned pk2(float lo, float hi) { return f2bf(lo) | (f2bf(hi) << 16); }
__device__ __forceinline__ float bflo(unsigned w) { return __builtin_bit_cast(float, w << 16); }
__device__ __forceinline__ float bfhi(unsigned w) { return __builtin_bit_cast(float, w & 0xffff0000u); }
__device__ __forceinline__ float fsigmoid(float x) { return __builtin_amdgcn_rcpf(1.0f + __expf(-x)); }
__device__ __forceinline__ float gelu_tanh(float x) { const float u = 1.5957691216057308f * (x + 0.044715f * x * x * x); return x * fsigmoid(u); }
__device__ __forceinline__ float wave_sum(float v) {
#pragma unroll
    for (int o = 1; o < 64; o <<= 1) v += __shfl_xor(v, o);
    return v;
}

namespace pg8 {
constexpr int BM = 256, BK = 64, HALF = 128, HTB = HALF * BK * 2, STAGE_BYTES = 8 * HTB, NXCD = 8, WGM = 4;
__host__ __device__ __forceinline__ int lds_byte(int r, int c) { const int st = (r >> 4) * 2 + (c >> 5), rr = r & 15, cc = c & 31, ob = rr * 64 + cc * 2; return st * 1024 + (ob ^ (((ob >> 9) & 1) << 5)); }
__host__ __device__ __forceinline__ void stage_rc(int b, int& R, int& C) { const int st = b / 1024, sb = b % 1024, swz = sb ^ (((sb >> 9) & 1) << 5); R = (st >> 1) * 16 + swz / 64; C = (st & 1) * 32 + (swz % 64) / 2; }
__host__ __device__ __forceinline__ int perm32(int rho) { const int n = rho >> 4, i = rho & 15; return 8 * (i >> 2) + 4 * n + (i & 3); }

struct Unit { int pm, pn, pb; };
struct Gemm { const bf16_t* A; const bf16_t* Bt; int lda, ldb, K; };

struct StaticOrder {
    int nM, nN, nwg, G, c, bdiv, wgm;
    __device__ void init(int nM_, int nN_, int G_, int c_, int bdiv_, int wgm_ = WGM) { nM = nM_; nN = nN_; nwg = nM * nN; G = G_; c = c_; bdiv = bdiv_; wgm = wgm_; }
    __device__ bool next(int i, Unit& u) const {
        const long L = (long)i * G + c; if (L >= nwg) return false;
        int wgid = (int)L; { const int q = nwg / NXCD, r = nwg % NXCD, xcd = wgid % NXCD, off = wgid / NXCD; wgid = (xcd < r ? xcd * (q + 1) : r * (q + 1) + (xcd - r) * q) + off; }
        const int nig = wgm * nN, gid = wgid / nig, fm = gid * wgm, gsz = (nM - fm) < wgm ? (nM - fm) : wgm;
        u.pm = fm + ((wgid % nig) % gsz); u.pn = (wgid % nig) / gsz; u.pb = bdiv ? (u.pm / bdiv) : u.pn; return true;
    }
};

__device__ __forceinline__ unsigned cvt_pk_bf16(float lo, float hi) { unsigned r; asm volatile("v_cvt_pk_bf16_f32 %0, %1, %2" : "=v"(r) : "v"(lo), "v"(hi)); return r; }

template <class Epi>
__device__ __forceinline__ void gemm_phase(LAS unsigned char* lds, const Gemm g, const StaticOrder& S, const Epi& E) {
    int tid_ = threadIdx.x; asm volatile("" : "+v"(tid_));
    const int tid = tid_, wid = __builtin_amdgcn_readfirstlane(tid >> 6), lane = tid & 63, wr = wid >> 2, wc = wid & 3, fr = lane & 15, fq = lane >> 4;
    int K_ = g.K; asm volatile("" : "+s"(K_));
    const int K = K_, nt = K / BK;
    unsigned voffA[2], voffB[2];
#pragma unroll
    for (int i = 0; i < 2; ++i) { int R, C; stage_rc(tid * 16 + i * 8192, R, C); const int Rb = Epi::PERM ? ((R & ~31) + perm32(R & 31)) : R;
        voffA[i] = (unsigned)(R * g.lda + C) * 2u; voffB[i] = (unsigned)(Rb * g.ldb + C) * 2u; }
    const size_t kstep = (size_t)(BK * 2);
    const size_t hstepA = (size_t)HALF * g.lda * 2, hstepB = (size_t)HALF * g.ldb * 2;
    const size_t tstepA = 2 * hstepA, tstepB = 2 * hstepB;
    const unsigned ldsw = (unsigned)wid * 1024u;
    const int aoff = lds_byte(wr * 64 + fr, fq * 8), boff = lds_byte(wc * 32 + fr, fq * 8);
#define PG8_SA(b, h) (((b) * 2 + (h)) * HTB)
#define PG8_SB(b, h) ((4 + (b) * 2 + (h)) * HTB)
#define PG8_STAGE(bufoff, gbase, voff) do { _Pragma("unroll") for (int _i = 0; _i < 2; ++_i) \
        __builtin_amdgcn_global_load_lds((const unsigned*)((const char*)(gbase) + (voff)[_i]), (LAS unsigned*)(lds + (bufoff) + ldsw + _i * 8192), 16, 0, 0); } while (0)
#define PG8_LDA(dst, b, h) do { _Pragma("unroll") for (int m = 0; m < 4; ++m) _Pragma("unroll") for (int k = 0; k < 2; ++k) dst[m][k] = *(const LAS bf16x8*)(lds + PG8_SA(b, h) + aoff + m * 2048 + k * 1024); } while (0)
#define PG8_LDB(dst, b, h) do { _Pragma("unroll") for (int n = 0; n < 2; ++n) _Pragma("unroll") for (int k = 0; k < 2; ++k) dst[n][k] = *(const LAS bf16x8*)(lds + PG8_SB(b, h) + boff + n * 2048 + k * 1024); } while (0)
#define PG8_MMA(ai, bj, At, Bt) do { __builtin_amdgcn_s_setprio(1); _Pragma("unroll") for (int m = 0; m < 4; ++m) _Pragma("unroll") for (int n = 0; n < 2; ++n) _Pragma("unroll") for (int k = 0; k < 2; ++k) \
        acc[ai][bj][m][n] = __builtin_amdgcn_mfma_f32_16x16x32_bf16(Bt[n][k], At[m][k], acc[ai][bj][m][n], 0, 0, 0); __builtin_amdgcn_s_setprio(0); } while (0)
#define PG8_WAIT_V(n) asm volatile("s_waitcnt vmcnt(" #n ")" ::: "memory")
#define PG8_WAIT_L(n) asm volatile("s_waitcnt lgkmcnt(" #n ")" ::: "memory")
#define PG8_BAR __builtin_amdgcn_s_barrier()
#define PG8_SCHED __builtin_amdgcn_sched_barrier(0)
    Unit cur, nxt; int ui = 0;
    if (!S.next(0, cur)) return;
    f32x4 acc[2][2][4][2];
#pragma unroll
    for (int a = 0; a < 2; ++a)
#pragma unroll
        for (int b = 0; b < 2; ++b)
#pragma unroll
            for (int m = 0; m < 4; ++m)
#pragma unroll
                for (int n = 0; n < 2; ++n) acc[a][b][m][n] = (f32x4){0.f, 0.f, 0.f, 0.f};
    bf16x8 At[4][2], B0[2][2], B1[2][2];
    const char* cA = (const char*)g.A + (size_t)cur.pm * tstepA; const char* cB = (const char*)g.Bt + (size_t)cur.pb * tstepB;
    PG8_STAGE(PG8_SB(0, 0), cB, voffB); PG8_STAGE(PG8_SB(0, 1), cB + hstepB, voffB); PG8_STAGE(PG8_SA(0, 0), cA, voffA); PG8_STAGE(PG8_SA(0, 1), cA + hstepA, voffA);
    if (wr == 1) PG8_BAR;
    PG8_WAIT_V(2); PG8_BAR;
    PG8_STAGE(PG8_SB(1, 0), cB + kstep, voffB); PG8_STAGE(PG8_SA(1, 0), cA + kstep, voffA); PG8_STAGE(PG8_SB(1, 1), cB + hstepB + kstep, voffB);
    PG8_WAIT_V(6); PG8_BAR;
    for (;;) {
        const bool has_next = S.next(ui + 1, nxt);
        const char* nA = has_next ? (const char*)g.A + (size_t)nxt.pm * tstepA : cA; const char* nB = has_next ? (const char*)g.Bt + (size_t)nxt.pb * tstepB : cB;
        for (int t = 0; t < nt; t += 2) {
            const bool last = (t == nt - 2);
            const char* a1 = cA + (size_t)(t + 1) * kstep;
            const char* a2 = last ? nA : cA + (size_t)(t + 2) * kstep; const char* b2 = last ? nB : cB + (size_t)(t + 2) * kstep;
            const char* a3 = a2 + kstep; const char* b3 = b2 + kstep;
            PG8_LDB(B0, 0, 0); PG8_LDB(B1, 0, 1); PG8_SCHED; PG8_LDA(At, 0, 0); PG8_STAGE(PG8_SA(1, 1), a1 + hstepA, voffA);
            PG8_WAIT_V(8); PG8_WAIT_L(0); PG8_BAR; PG8_MMA(0, 0, At, B0); PG8_MMA(0, 1, At, B1); PG8_BAR; PG8_SCHED;
            PG8_LDA(At, 0, 1); PG8_STAGE(PG8_SB(0, 0), b2, voffB); PG8_STAGE(PG8_SB(0, 1), b2 + hstepB, voffB); PG8_STAGE(PG8_SA(0, 0), a2, voffA);
            PG8_WAIT_V(8); PG8_WAIT_L(0); PG8_BAR; PG8_MMA(1, 0, At, B0); PG8_MMA(1, 1, At, B1); PG8_BAR; PG8_SCHED;
            PG8_LDB(B0, 1, 0); PG8_LDB(B1, 1, 1); PG8_SCHED; PG8_LDA(At, 1, 0); PG8_STAGE(PG8_SA(0, 1), a2 + hstepA, voffA);
            PG8_WAIT_V(8); PG8_WAIT_L(0); PG8_BAR; PG8_MMA(0, 0, At, B0); PG8_MMA(0, 1, At, B1); PG8_BAR; PG8_SCHED;
            PG8_LDA(At, 1, 1); PG8_STAGE(PG8_SB(1, 0), b3, voffB); PG8_STAGE(PG8_SB(1, 1), b3 + hstepB, voffB); PG8_STAGE(PG8_SA(1, 0), a3, voffA);
            PG8_WAIT_V(8); PG8_WAIT_L(0); PG8_BAR; PG8_MMA(1, 0, At, B0); PG8_MMA(1, 1, At, B1); PG8_BAR; PG8_SCHED;
        }
        if (wr == 0) PG8_BAR;
        E(acc, cur, wr, wc, fr, fq);
        if (!has_next) break;
#pragma unroll
        for (int a = 0; a < 2; ++a)
#pragma unroll
            for (int b = 0; b < 2; ++b)
#pragma unroll
                for (int m = 0; m < 4; ++m)
#pragma unroll
                    for (int n = 0; n < 2; ++n) acc[a][b][m][n] = (f32x4){0.f, 0.f, 0.f, 0.f};
        cur = nxt; cA = nA; cB = nB; ++ui;
        if (wr == 1) PG8_BAR;
    }
    PG8_WAIT_V(0);
    PG8_BAR;
#undef PG8_SA
#undef PG8_SB
#undef PG8_STAGE
#undef PG8_LDA
#undef PG8_LDB
#undef PG8_MMA
#undef PG8_WAIT_V
#undef PG8_WAIT_L
#undef PG8_BAR
#undef PG8_SCHED
}

typedef f32x4 Acc[2][2][4][2];
struct EpiSwiGLU {
    static constexpr bool PERM = true;
    bf16_t* H; const float* ss;
    __device__ __forceinline__ void operator()(const Acc& acc, const Unit& u, int wr, int wc, int fr, int fq) const {
        float rsv[2][4];
#pragma unroll
        for (int ai = 0; ai < 2; ++ai)
#pragma unroll
            for (int m = 0; m < 4; ++m) rsv[ai][m] = ss ? ss[(size_t)u.pm * BM + ai * HALF + wr * 64 + m * 16 + fr] : 0.f;
#pragma unroll
        for (int ai = 0; ai < 2; ++ai)
#pragma unroll
            for (int m = 0; m < 4; ++m) rsv[ai][m] = ss ? rsqrtf(rsv[ai][m] * (1.f / DM) + EPS) : 1.f;
        const int j0 = u.pn * HALF + wc * 32 + 8 * fq;
#pragma unroll
        for (int ai = 0; ai < 2; ++ai)
#pragma unroll
            for (int m = 0; m < 4; ++m) { const size_t row = (size_t)u.pm * BM + ai * HALF + wr * 64 + m * 16 + fr; const float rs = rsv[ai][m]; float h[8];
#pragma unroll
                for (int n = 0; n < 2; ++n) { const f32x4 gt = acc[ai][0][m][n] * rs, up = acc[ai][1][m][n] * rs;
#pragma unroll
                    for (int e = 0; e < 4; ++e) h[4 * n + e] = gt[e] * fsigmoid(gt[e]) * up[e]; }
                u32x4 w; w.x = cvt_pk_bf16(h[0], h[1]); w.y = cvt_pk_bf16(h[2], h[3]); w.z = cvt_pk_bf16(h[4], h[5]); w.w = cvt_pk_bf16(h[6], h[7]);
                *(u32x4*)(H + row * FF + j0) = w; }
    }
};
template <bool XBASE> struct EpiResid {
    static constexpr bool PERM = true;
    const float* basef; bf16_t* H; float* ss; float scale; LAS float* P;
    __device__ __forceinline__ void operator()(Acc& acc, const Unit& u, int wr, int wc, int fr, int fq) const {
        const size_t off0 = ((size_t)u.pm * BM + wr * 64 + fr) * DM + u.pn * BM + wc * 32 + 8 * fq;
        float parts[2][4];
        u32x4 pa[2][2], pb[2][2];
#define ER_LOAD(ai, mp) _Pragma("unroll") for (int mm = 0; mm < 2; ++mm) _Pragma("unroll") for (int bj = 0; bj < 2; ++bj) { const size_t o2 = off0 + (size_t)((ai) * HALF + (2 * (mp) + mm) * 16) * DM + bj * HALF; \
            if constexpr (XBASE) { pa[mm][bj] = *(const u32x4*)(basef + o2); pb[mm][bj] = *(const u32x4*)(basef + o2 + 4); } else { pa[mm][bj] = *(const u32x4*)(H + o2); } }
#define ER_SUM(ai, mp) _Pragma("unroll") for (int mm = 0; mm < 2; ++mm) _Pragma("unroll") for (int bj = 0; bj < 2; ++bj) { f32x4 b0, b1; const u32x4 A = pa[mm][bj]; \
            if constexpr (XBASE) { b0 = __builtin_bit_cast(f32x4, A); b1 = __builtin_bit_cast(f32x4, pb[mm][bj]); } \
            else { b0 = (f32x4){bflo(A.x), bfhi(A.x), bflo(A.y), bfhi(A.y)}; b1 = (f32x4){bflo(A.z), bfhi(A.z), bflo(A.w), bfhi(A.w)}; } \
            acc[ai][bj][2 * (mp) + mm][0] = b0 + acc[ai][bj][2 * (mp) + mm][0] * scale; acc[ai][bj][2 * (mp) + mm][1] = b1 + acc[ai][bj][2 * (mp) + mm][1] * scale; }
#define ER_STORE(ai, mp) _Pragma("unroll") for (int mm = 0; mm < 2; ++mm) { const int m = 2 * (mp) + mm; const size_t o1 = off0 + (size_t)((ai) * HALF + m * 16) * DM; float part = 0.f; \
            _Pragma("unroll") for (int bj = 0; bj < 2; ++bj) { const size_t o2 = o1 + bj * HALF; const f32x4 v = acc[ai][bj][m][0], v2 = acc[ai][bj][m][1]; \
                part += ((v[0] * v[0] + v[1] * v[1]) + (v[2] * v[2] + v[3] * v[3])) + ((v2[0] * v2[0] + v2[1] * v2[1]) + (v2[2] * v2[2] + v2[3] * v2[3])); \
                u32x4 w; w.x = cvt_pk_bf16(v[0], v[1]); w.y = cvt_pk_bf16(v[2], v[3]); w.z = cvt_pk_bf16(v2[0], v2[1]); w.w = cvt_pk_bf16(v2[2], v2[3]); *(u32x4*)(H + o2) = w; } \
            parts[ai][m] = part; }
        ER_LOAD(0, 0) ER_SUM(0, 0) asm volatile("" ::: "memory"); ER_LOAD(0, 1) asm volatile("" ::: "memory"); ER_STORE(0, 0) ER_SUM(0, 1) asm volatile("" ::: "memory");
        ER_LOAD(1, 0) asm volatile("" ::: "memory"); ER_STORE(0, 1) ER_SUM(1, 0) asm volatile("" ::: "memory"); ER_LOAD(1, 1) asm volatile("" ::: "memory"); ER_STORE(1, 0) ER_SUM(1, 1) ER_STORE(1, 1)
#undef ER_LOAD
#undef ER_SUM
#undef ER_STORE
#pragma unroll
        for (int ai = 0; ai < 2; ++ai)
#pragma unroll
            for (int m = 0; m < 4; ++m) { float p = parts[ai][m]; p += __shfl_xor(p, 16); p += __shfl_xor(p, 32); if (fq == 0) P[(ai * HALF + wr * 64 + m * 16 + fr) * 4 + wc] = p; }
        asm volatile("s_waitcnt lgkmcnt(0)" ::: "memory"); __builtin_amdgcn_s_barrier(); asm volatile("" ::: "memory");
        { const int lane = fr + 16 * fq, wid = wr * 4 + wc;
          if (lane < 32) { const int r = wid * 32 + lane; const f32x4 q = *(const LAS f32x4*)(P + r * 4);
              (void)__hip_atomic_fetch_add(ss + (size_t)u.pm * BM + r, (q[0] + q[1]) + (q[2] + q[3]), __ATOMIC_RELAXED, __HIP_MEMORY_SCOPE_AGENT); } }
    }
};
struct EpiPleGate {
    static constexpr bool PERM = true;
    bf16_t* O; const bf16_t* H; const bf16_t* P; const float* ss;
    __device__ __forceinline__ void operator()(Acc& acc, const Unit& u, int wr, int wc, int fr, int fq) const {
        const size_t row0 = (size_t)u.pm * BM + wr * 64 + fr; const size_t off0 = row0 * DM + u.pn * BM + wc * 32 + 8 * fq;
        float rsv[2][4];
#pragma unroll
        for (int ai = 0; ai < 2; ++ai)
#pragma unroll
            for (int m = 0; m < 4; ++m) rsv[ai][m] = ss[row0 + ai * HALF + m * 16];
#pragma unroll
        for (int ai = 0; ai < 2; ++ai)
#pragma unroll
            for (int m = 0; m < 4; ++m) rsv[ai][m] = rsqrtf(rsv[ai][m] * (1.f / DM) + EPS);
        u32x4 ph[2][2], pp[2][2];
#define PG_LOAD(ai, mp) _Pragma("unroll") for (int mm = 0; mm < 2; ++mm) _Pragma("unroll") for (int bj = 0; bj < 2; ++bj) { \
            const size_t o2 = off0 + (size_t)((ai) * HALF + (2 * (mp) + mm) * 16) * DM + bj * HALF; ph[mm][bj] = *(const u32x4*)(H + o2); pp[mm][bj] = *(const u32x4*)(P + o2); }
#define PG_SUM(ai, mp) _Pragma("unroll") for (int mm = 0; mm < 2; ++mm) _Pragma("unroll") for (int bj = 0; bj < 2; ++bj) { const float rs = rsv[ai][2 * (mp) + mm]; const u32x4 h = ph[mm][bj], pw = pp[mm][bj]; \
            { const f32x4 a = acc[ai][bj][2 * (mp) + mm][0] * rs; f32x4 v; v[0] = bflo(h.x) + fsigmoid(a[0]) * bflo(pw.x); v[1] = bfhi(h.x) + fsigmoid(a[1]) * bfhi(pw.x); \
              v[2] = bflo(h.y) + fsigmoid(a[2]) * bflo(pw.y); v[3] = bfhi(h.y) + fsigmoid(a[3]) * bfhi(pw.y); acc[ai][bj][2 * (mp) + mm][0] = v; } \
            { const f32x4 a = acc[ai][bj][2 * (mp) + mm][1] * rs; f32x4 v; v[0] = bflo(h.z) + fsigmoid(a[0]) * bflo(pw.z); v[1] = bfhi(h.z) + fsigmoid(a[1]) * bfhi(pw.z); \
              v[2] = bflo(h.w) + fsigmoid(a[2]) * bflo(pw.w); v[3] = bfhi(h.w) + fsigmoid(a[3]) * bfhi(pw.w); acc[ai][bj][2 * (mp) + mm][1] = v; } }
#define PG_STORE(ai, mp) _Pragma("unroll") for (int mm = 0; mm < 2; ++mm) _Pragma("unroll") for (int bj = 0; bj < 2; ++bj) { const f32x4 v = acc[ai][bj][2 * (mp) + mm][0], v2 = acc[ai][bj][2 * (mp) + mm][1]; \
            u32x4 w; w.x = cvt_pk_bf16(v[0], v[1]); w.y = cvt_pk_bf16(v[2], v[3]); w.z = cvt_pk_bf16(v2[0], v2[1]); w.w = cvt_pk_bf16(v2[2], v2[3]); \
            *(u32x4*)(O + off0 + (size_t)((ai) * HALF + (2 * (mp) + mm) * 16) * DM + bj * HALF) = w; }
        PG_LOAD(0, 0) PG_SUM(0, 0) asm volatile("" ::: "memory"); PG_LOAD(0, 1) asm volatile("" ::: "memory"); PG_STORE(0, 0) PG_SUM(0, 1) asm volatile("" ::: "memory");
        PG_LOAD(1, 0) asm volatile("" ::: "memory"); PG_STORE(0, 1) PG_SUM(1, 0) asm volatile("" ::: "memory"); PG_LOAD(1, 1) asm volatile("" ::: "memory"); PG_STORE(1, 0) PG_SUM(1, 1) PG_STORE(1, 1)
#undef PG_LOAD
#undef PG_SUM
#undef PG_STORE
    }
};
struct EpiBf16 {
    static constexpr bool PERM = true;
    bf16_t* O; int ldc;
    __device__ __forceinline__ void operator()(const Acc& acc, const Unit& u, int wr, int wc, int fr, int fq) const {
#pragma unroll
        for (int ai = 0; ai < 2; ++ai)
#pragma unroll
            for (int m = 0; m < 4; ++m) { bf16_t* rowp = O + ((size_t)u.pm * BM + ai * HALF + wr * 64 + m * 16 + fr) * ldc + u.pn * BM + wc * 32 + 8 * fq;
#pragma unroll
                for (int bj = 0; bj < 2; ++bj) { const f32x4 v0 = acc[ai][bj][m][0], v1 = acc[ai][bj][m][1];
                    u32x4 w; w.x = cvt_pk_bf16(v0[0], v0[1]); w.y = cvt_pk_bf16(v0[2], v0[3]); w.z = cvt_pk_bf16(v1[0], v1[1]); w.w = cvt_pk_bf16(v1[2], v1[3]);
                    *(u32x4*)(rowp + bj * HALF) = w; } }
    }
};
struct EpiWin {
    static constexpr bool PERM = true;
    bf16_t* QKV; bf16_t* AS; const float* ss;
    __device__ __forceinline__ void operator()(const Acc& acc, const Unit& u, int wr, int wc, int fr, int fq) const {
        float rsv[2][4];
#pragma unroll
        for (int ai = 0; ai < 2; ++ai)
#pragma unroll
            for (int m = 0; m < 4; ++m) rsv[ai][m] = ss[u.pm * BM + ai * HALF + wr * 64 + m * 16 + fr];
#pragma unroll
        for (int ai = 0; ai < 2; ++ai)
#pragma unroll
            for (int m = 0; m < 4; ++m) rsv[ai][m] = rsqrtf(rsv[ai][m] * (1.f / DM) + EPS);
#pragma unroll
        for (int ai = 0; ai < 2; ++ai)
#pragma unroll
            for (int m = 0; m < 4; ++m) { const int row = u.pm * BM + ai * HALF + wr * 64 + m * 16 + fr;
                const float rs = rsv[ai][m];
#pragma unroll
                for (int bj = 0; bj < 2; ++bj) { const f32x4 v0 = acc[ai][bj][m][0] * rs, v1 = acc[ai][bj][m][1] * rs;
                    u32x4 w; w.x = cvt_pk_bf16(v0[0], v0[1]); w.y = cvt_pk_bf16(v0[2], v0[3]); w.z = cvt_pk_bf16(v1[0], v1[1]); w.w = cvt_pk_bf16(v1[2], v1[3]);
                    const int col0 = u.pn * BM + bj * HALF + wc * 32 + 8 * fq;
                    if (u.pn < 12) { const int which = col0 >> 10, hcol = col0 & 1023; *(u32x4*)(QKV + ((size_t)((which * 4 + (row >> 13)) * 16 + (hcol >> 6)) * SEQ + (row & 8191)) * 64 + (hcol & 63)) = w; }
                    else { const int ch = col0 - 3072, g = ch >> 4, c = ch & 15, b = row >> 13, t = row & 8191, chunk = t >> 4, tt = t & 15;
                        *(u32x4*)(AS + ((size_t)g * ROWS_G + b * NCH + chunk) * KT + tt * 16 + c) = w; } } }
    }
};
struct EpiE {
    static constexpr bool PERM = false;
    float* E;
    __device__ __forceinline__ void operator()(const Acc& acc, const Unit& u, int wr, int wc, int fr, int fq) const {
#pragma unroll
        for (int ai = 0; ai < 2; ++ai)
#pragma unroll
            for (int m = 0; m < 4; ++m) { float* rowp = E + ((size_t)u.pm * BM + ai * HALF + wr * 64 + m * 16 + fr) * 128 + wc * 32 + 4 * fq;
#pragma unroll
                for (int n = 0; n < 2; ++n) *(f32x4*)(rowp + n * 16) = acc[ai][0][m][n]; }
    }
};
struct EpiToep {
    static constexpr bool PERM = true;
    bf16_t* Y;
    __device__ __forceinline__ void operator()(const Acc& acc, const Unit& u, int wr, int wc, int fr, int fq) const {
#pragma unroll
        for (int ai = 0; ai < 2; ++ai)
#pragma unroll
            for (int m = 0; m < 4; ++m) { const int row = u.pm * BM + ai * HALF + wr * 64 + m * 16 + fr; const int g = row >> 11, rb = row & 2047, b = rb >> 9, chunk = rb & 511;
#pragma unroll
                for (int bj = 0; bj < 2; ++bj) { const f32x4 v0 = acc[ai][bj][m][0], v1 = acc[ai][bj][m][1];
                    u32x4 w; w.x = cvt_pk_bf16(gelu_tanh(v0[0]), gelu_tanh(v0[1])); w.y = cvt_pk_bf16(gelu_tanh(v0[2]), gelu_tanh(v0[3]));
                    w.z = cvt_pk_bf16(gelu_tanh(v1[0]), gelu_tanh(v1[1])); w.w = cvt_pk_bf16(gelu_tanh(v1[2]), gelu_tanh(v1[3]));
                    const int col0 = bj * HALF + wc * 32 + 8 * fq, tt = col0 >> 4, co = col0 & 15;
                    *(u32x4*)(Y + ((size_t)b * SEQ + chunk * LC + tt) * SW + g * 16 + co) = w; } }
    }
};
struct EpiGLU {
    static constexpr bool PERM = true;
    const bf16_t* Y; const float* bias; bf16_t* O;
    __device__ __forceinline__ void operator()(const Acc& acc, const Unit& u, int wr, int wc, int fr, int fq) const {
        const size_t off0 = ((size_t)u.pm * BM + wr * 64 + fr) * SW + u.pn * BM + wc * 32 + 8 * fq;
        f32x4 bv[2][2]; u32x4 yv[2][4][2];
#pragma unroll
        for (int bj = 0; bj < 2; ++bj) { bv[bj][0] = *(const f32x4*)(bias + u.pn * BM + bj * HALF + wc * 32 + 8 * fq); bv[bj][1] = *(const f32x4*)(bias + u.pn * BM + bj * HALF + wc * 32 + 8 * fq + 4); }
#pragma unroll
        for (int ai = 0; ai < 2; ++ai)
#pragma unroll
            for (int m = 0; m < 4; ++m)
#pragma unroll
                for (int bj = 0; bj < 2; ++bj) yv[ai][m][bj] = *(const u32x4*)(Y + off0 + (size_t)(ai * HALF + m * 16) * SW + bj * HALF);
        asm volatile("" ::: "memory");
#pragma unroll
        for (int ai = 0; ai < 2; ++ai)
#pragma unroll
            for (int m = 0; m < 4; ++m)
#pragma unroll
                for (int bj = 0; bj < 2; ++bj) { const f32x4 v0 = acc[ai][bj][m][0] + bv[bj][0], v1 = acc[ai][bj][m][1] + bv[bj][1]; const u32x4 y = yv[ai][m][bj];
                    u32x4 w; w.x = cvt_pk_bf16(bflo(y.x) * fsigmoid(v0[0]), bfhi(y.x) * fsigmoid(v0[1])); w.y = cvt_pk_bf16(bflo(y.y) * fsigmoid(v0[2]), bfhi(y.y) * fsigmoid(v0[3]));
                    w.z = cvt_pk_bf16(bflo(y.z) * fsigmoid(v1[0]), bfhi(y.z) * fsigmoid(v1[1])); w.w = cvt_pk_bf16(bflo(y.w) * fsigmoid(v1[2]), bfhi(y.w) * fsigmoid(v1[3]));
                    *(u32x4*)(O + off0 + (size_t)(ai * HALF + m * 16) * SW + bj * HALF) = w; }
    }
};
}

#define XB_TMO      128
#define XB_XCNT(j)  (256  + 64 * (j))
#define XB_XSUB(j)  (1280 + 64 * (j))
#define XB_XGEN(j)  (2304 + 64 * (j))
#define XB_TOP      3328
#define XB_TOPGEN   3392
#define XCD_BAR_WORDS 3456
#define XB_SPIN_CAP (1u << 23)
__device__ __forceinline__ unsigned xb_ld(unsigned* p)              { return __hip_atomic_load(p, __ATOMIC_RELAXED, __HIP_MEMORY_SCOPE_AGENT); }
__device__ __forceinline__ unsigned xb_add(unsigned* p, unsigned v) { return __hip_atomic_fetch_add(p, v, __ATOMIC_RELAXED, __HIP_MEMORY_SCOPE_AGENT); }
__device__ __forceinline__ unsigned xb_xcc_id() { return (unsigned)__builtin_amdgcn_s_getreg((3 << 11) | 20) & 0xFu; }
#define XB_SPIN(cond, bar) do { unsigned _sp = 0; while (cond) { __builtin_amdgcn_s_sleep(1); \
    if ((++_sp & 255u) == 0u) { if (xb_ld(&(bar)[XB_TMO])) break; if (_sp > XB_SPIN_CAP) { atomicAdd(&(bar)[XB_TMO], 1u); break; } } } } while (0)
struct XcdBarrier { unsigned* bar; unsigned x; volatile LAS unsigned* st; };
__device__ __forceinline__ XcdBarrier xcd_barrier_post(unsigned* bar, volatile LAS unsigned* st) {
    XcdBarrier b; b.bar = bar; b.x = xb_xcc_id(); b.st = st;
    if (threadIdx.x == 0) (void)xb_add(&bar[XB_XCNT(b.x)], 1u);
    return b;
}
__device__ __forceinline__ void xcd_barrier_complete(unsigned* bar, unsigned x, unsigned& nloc, unsigned& nx) {
    const unsigned G = gridDim.x * gridDim.y * gridDim.z;
    unsigned sum, cnt, mine, sp = 0u;
    for (;;) {
        sum = 0u; cnt = 0u; mine = 0u;
#pragma unroll
        for (unsigned j = 0; j < 16; ++j) { const unsigned c = xb_ld(&bar[XB_XCNT(j)]); sum += c; cnt += (c > 0u) ? 1u : 0u; mine = (j == x) ? c : mine; }
        if (sum == G) break;
        __builtin_amdgcn_s_sleep(1);
        if ((++sp & 255u) == 0u) { if (xb_ld(&bar[XB_TMO])) break; if (sp > XB_SPIN_CAP) { atomicAdd(&bar[XB_TMO], 1u); break; } }
    }
    nloc = mine > 0u ? mine : 1u; nx = cnt > 0u ? cnt : 1u;
}
__device__ __forceinline__ void xcd_barrier(const XcdBarrier& b) {
    asm volatile("s_waitcnt vmcnt(0)" ::: "memory");
    __syncthreads();
    if (threadIdx.x == 0) {
        unsigned* bar = b.bar;
        __builtin_amdgcn_s_waitcnt(0);
        unsigned nloc = b.st[0], nx = b.st[1];
        if (nloc == 0u) { xcd_barrier_complete(bar, b.x, nloc, nx); b.st[0] = nloc; b.st[1] = nx; }
        const unsigned old = xb_add(&bar[XB_XSUB(b.x)], 1u);
        const unsigned gen = old / nloc;
        if (old + 1u == (gen + 1u) * nloc) {
            __builtin_amdgcn_fence(__ATOMIC_RELEASE, "agent");
            asm volatile("s_waitcnt vmcnt(0)" ::: "memory");
            const unsigned og = xb_add(&bar[XB_TOP], 1u);
            const unsigned tg = og / nx;
            if (og + 1u == (tg + 1u) * nx) xb_add(&bar[XB_TOPGEN], 1u);
            else XB_SPIN(xb_ld(&bar[XB_TOPGEN]) == tg, bar);
            __builtin_amdgcn_fence(__ATOMIC_ACQUIRE, "agent");
            xb_add(&bar[XB_XGEN(b.x)], 1u);
            asm volatile("s_waitcnt vmcnt(0)" ::: "memory");
        } else {
            XB_SPIN(xb_ld(&bar[XB_XGEN(b.x)]) == gen, bar);
            __builtin_amdgcn_fence(__ATOMIC_ACQUIRE, "agent");
            asm volatile("s_waitcnt vmcnt(0)" ::: "memory");
        }
    }
    __syncthreads();
}

struct Args { const float* in[29]; float* out; unsigned char* ws; };
enum { I_X = 0, I_P, I_F1N, I_F1G, I_F1U, I_F1D, I_MIXN, I_WIN, I_AON, I_LRE, I_LIM, I_LDT, I_BRE, I_BIM, I_CRE, I_CIM, I_SD, I_WGLU, I_BGLU, I_SON, I_WOUT,
       I_F2N, I_F2G, I_F2U, I_F2D, I_PLN, I_WPG, I_WPLE, I_FINN };

__device__ __forceinline__ void transpose_item(const float* W, const float* gain, int K, int N, bf16_t* WT, int mode, LAS float* scr, int item, int lane) {
    const int nblk = N / 64, kb = item / nblk, nb = item % nblk, k0 = 64 * kb, n0 = 64 * nb;
    const int kl = lane >> 4, n4 = lane & 15;
    f32x4 tv[16];
#pragma unroll
    for (int i = 0; i < 16; ++i) tv[i] = *(const f32x4*)(W + (size_t)(k0 + 4 * i + kl) * N + n0 + 4 * n4);
#pragma unroll
    for (int i = 0; i < 16; ++i) { const int kk = 4 * i + kl; f32x4 v = tv[i];
        if (gain) v = v * gain[k0 + kk];
        LAS float* d = scr + kk * 65 + 4 * n4; d[0] = v[0]; d[1] = v[1]; d[2] = v[2]; d[3] = v[3]; }
    asm volatile("s_waitcnt lgkmcnt(0)" ::: "memory");
    const int c = lane & 7;
#pragma unroll
    for (int j = 0; j < 8; ++j) { const int n = (lane >> 3) + 8 * j; const LAS float* s = scr + (8 * c) * 65 + n;
        u32x4 o; o.x = pk2(s[0 * 65], s[1 * 65]); o.y = pk2(s[2 * 65], s[3 * 65]); o.z = pk2(s[4 * 65], s[5 * 65]); o.w = pk2(s[6 * 65], s[7 * 65]);
        const int ns = n0 + n; const int dr = (mode == 0) ? ns : (((ns >> 7) << 8) + (ns & 127) + (mode == 2 ? 128 : 0));
        *(u32x4*)(WT + (size_t)dr * K + k0 + 8 * c) = o; }
    asm volatile("s_waitcnt lgkmcnt(0)" ::: "memory");
}

template <int SET>
__device__ __forceinline__ void transpose_set(const Args& a, LAS float* scr, int gw, int NGW, int lane) {
    unsigned char* ws = a.ws;
    constexpr int I_GU = (DM / 64) * (FF / 64), I_DN = (FF / 64) * (DM / 64), I_IN = (DM / 64) * (NIN / 64), I_SQ = (DM / 64) * (DM / 64), I_PL = (PLE / 64) * (DM / 64), I_GL = (SW / 64) * (SW / 64);
    if constexpr (SET == 0) {
        constexpr int NITEMS = 2 * I_GU + I_DN + I_IN + I_SQ + I_GL;
        for (int it = gw; it < NITEMS; it += NGW) {
            int r = it;
            if (r < I_GU) { transpose_item(a.in[I_F1G], nullptr, DM, FF, (bf16_t*)(ws + WS_GU1), 1, scr, r, lane); continue; } r -= I_GU;
            if (r < I_GU) { transpose_item(a.in[I_F1U], nullptr, DM, FF, (bf16_t*)(ws + WS_GU1), 2, scr, r, lane); continue; } r -= I_GU;
            if (r < I_DN) { transpose_item(a.in[I_F1D], nullptr, FF, DM, (bf16_t*)(ws + WS_DN1), 0, scr, r, lane); continue; } r -= I_DN;
            if (r < I_IN) { transpose_item(a.in[I_WIN], a.in[I_MIXN], DM, NIN, (bf16_t*)(ws + WS_WIN), 0, scr, r, lane); continue; } r -= I_IN;
            if (r < I_SQ) { transpose_item(a.in[I_WOUT], nullptr, DM, DM, (bf16_t*)(ws + WS_WOUT), 0, scr, r, lane); continue; } r -= I_SQ;
            transpose_item(a.in[I_WGLU], nullptr, SW, SW, (bf16_t*)(ws + WS_WGLU), 0, scr, r, lane);
        }
    } else {
        constexpr int NITEMS = 2 * I_GU + I_DN + I_SQ + I_PL;
        for (int it = gw; it < NITEMS; it += NGW) {
            int r = it;
            if (r < I_GU) { transpose_item(a.in[I_F2G], a.in[I_F2N], DM, FF, (bf16_t*)(ws + WS_GU2), 1, scr, r, lane); continue; } r -= I_GU;
            if (r < I_GU) { transpose_item(a.in[I_F2U], a.in[I_F2N], DM, FF, (bf16_t*)(ws + WS_GU2), 2, scr, r, lane); continue; } r -= I_GU;
            if (r < I_DN) { transpose_item(a.in[I_F2D], nullptr, FF, DM, (bf16_t*)(ws + WS_DN2), 0, scr, r, lane); continue; } r -= I_DN;
            if (r < I_SQ) { transpose_item(a.in[I_WPG], a.in[I_PLN], DM, DM, (bf16_t*)(ws + WS_WPG), 0, scr, r, lane); continue; } r -= I_SQ;
            transpose_item(a.in[I_WPLE], nullptr, PLE, DM, (bf16_t*)(ws + WS_WPLE), 0, scr, r, lane);
        }
    }
}

__device__ __forceinline__ void rms_row_bf16(const float* xrow, const float* gain, bf16_t* orow, int lane) {
    const f32x4* xr = (const f32x4*)xrow + lane; const f32x4* gr = (const f32x4*)gain + lane;
    f32x4 v[8]; float s = 0.f;
#pragma unroll
    for (int j = 0; j < 8; ++j) { v[j] = xr[64 * j]; s += (v[j][0] * v[j][0] + v[j][1] * v[j][1]) + (v[j][2] * v[j][2] + v[j][3] * v[j][3]); }
    const float rstd = rsqrtf(wave_sum(s) * (1.f / DM) + EPS);
    u32x2* o8 = (u32x2*)orow + lane;
#pragma unroll
    for (int j = 0; j < 8; ++j) { const f32x4 g = gr[64 * j]; u32x2 w; w.x = pk2(v[j][0] * rstd * g[0], v[j][1] * rstd * g[1]); w.y = pk2(v[j][2] * rstd * g[2], v[j][3] * rstd * g[3]); o8[64 * j] = w; }
}
__device__ __forceinline__ void rms_row_f32(float* xrow, const float* gain, int lane) {
    f32x4* xr = (f32x4*)xrow + lane; const f32x4* gr = (const f32x4*)gain + lane;
    f32x4 v[8]; float s = 0.f;
#pragma unroll
    for (int j = 0; j < 8; ++j) { v[j] = xr[64 * j]; s += (v[j][0] * v[j][0] + v[j][1] * v[j][1]) + (v[j][2] * v[j][2] + v[j][3] * v[j][3]); }
    const float rstd = rsqrtf(wave_sum(s) * (1.f / DM) + EPS);
#pragma unroll
    for (int j = 0; j < 8; ++j) { const f32x4 g = gr[64 * j]; xr[64 * j] = v[j] * rstd * g; }
}

__device__ __forceinline__ void rms_row2_bf16(const float* x0, const float* x1, const float* gain, bf16_t* o0, bf16_t* o1, int lane) {
    const f32x4* xa = (const f32x4*)x0 + lane; const f32x4* xb = (const f32x4*)x1 + lane; const f32x4* gr = (const f32x4*)gain + lane;
    f32x4 va[8], vb[8]; float sa = 0.f, sb = 0.f;
#pragma unroll
    for (int j = 0; j < 8; ++j) va[j] = xa[64 * j];
#pragma unroll
    for (int j = 0; j < 8; ++j) vb[j] = xb[64 * j];
#pragma unroll
    for (int j = 0; j < 8; ++j) { sa += (va[j][0] * va[j][0] + va[j][1] * va[j][1]) + (va[j][2] * va[j][2] + va[j][3] * va[j][3]); sb += (vb[j][0] * vb[j][0] + vb[j][1] * vb[j][1]) + (vb[j][2] * vb[j][2] + vb[j][3] * vb[j][3]); }
    const float ra = rsqrtf(wave_sum(sa) * (1.f / DM) + EPS), rb = rsqrtf(wave_sum(sb) * (1.f / DM) + EPS);
    u32x2* pa = (u32x2*)o0 + lane; u32x2* pb = (u32x2*)o1 + lane;
#pragma unroll
    for (int j = 0; j < 8; ++j) { const f32x4 g = gr[64 * j]; u32x2 w; w.x = pk2(va[j][0] * ra * g[0], va[j][1] * ra * g[1]); w.y = pk2(va[j][2] * ra * g[2], va[j][3] * ra * g[3]); pa[64 * j] = w;
        u32x2 w2; w2.x = pk2(vb[j][0] * rb * g[0], vb[j][1] * rb * g[1]); w2.y = pk2(vb[j][2] * rb * g[2], vb[j][3] * rb * g[3]); pb[64 * j] = w2; }
}
__device__ __forceinline__ void rms_row2_out(const bf16_t* x0, const bf16_t* x1, float* y0, float* y1, const float* gain, int lane) {
    const u32x4* xa = (const u32x4*)x0 + lane; const u32x4* xb = (const u32x4*)x1 + lane;
    u32x4 ra4[4], rb4[4];
#pragma unroll
    for (int j = 0; j < 4; ++j) ra4[j] = xa[64 * j];
#pragma unroll
    for (int j = 0; j < 4; ++j) rb4[j] = xb[64 * j];
    float va[4][8], vb[4][8]; float sa = 0.f, sb = 0.f;
#pragma unroll
    for (int j = 0; j < 4; ++j) { const u32x4 A = ra4[j], B = rb4[j];
        va[j][0] = bflo(A.x); va[j][1] = bfhi(A.x); va[j][2] = bflo(A.y); va[j][3] = bfhi(A.y); va[j][4] = bflo(A.z); va[j][5] = bfhi(A.z); va[j][6] = bflo(A.w); va[j][7] = bfhi(A.w);
        vb[j][0] = bflo(B.x); vb[j][1] = bfhi(B.x); vb[j][2] = bflo(B.y); vb[j][3] = bfhi(B.y); vb[j][4] = bflo(B.z); vb[j][5] = bfhi(B.z); vb[j][6] = bflo(B.w); vb[j][7] = bfhi(B.w);
#pragma unroll
        for (int e = 0; e < 8; ++e) { sa += va[j][e] * va[j][e]; sb += vb[j][e] * vb[j][e]; } }
    const float ra = rsqrtf(wave_sum(sa) * (1.f / DM) + EPS), rb = rsqrtf(wave_sum(sb) * (1.f / DM) + EPS);
    const f32x4* gr = (const f32x4*)gain + 2 * lane; f32x4* ya = (f32x4*)y0 + 2 * lane; f32x4* yb_ = (f32x4*)y1 + 2 * lane;
#pragma unroll
    for (int j = 0; j < 4; ++j) { const f32x4 g0 = gr[128 * j], g1 = gr[128 * j + 1];
        ya[128 * j] = (f32x4){va[j][0] * ra * g0[0], va[j][1] * ra * g0[1], va[j][2] * ra * g0[2], va[j][3] * ra * g0[3]};
        ya[128 * j + 1] = (f32x4){va[j][4] * ra * g1[0], va[j][5] * ra * g1[1], va[j][6] * ra * g1[2], va[j][7] * ra * g1[3]};
        yb_[128 * j] = (f32x4){vb[j][0] * rb * g0[0], vb[j][1] * rb * g0[1], vb[j][2] * rb * g0[2], vb[j][3] * rb * g0[3]};
        yb_[128 * j + 1] = (f32x4){vb[j][4] * rb * g1[0], vb[j][5] * rb * g1[1], vb[j][6] * rb * g1[2], vb[j][7] * rb * g1[3]}; }
}

__device__ __forceinline__ void ssm_precompute(const Args& a, int g, LAS unsigned char* lds, int tid) {
    LAS float* pwr = (LAS float*)lds;
    LAS float* pwi = pwr + 17 * 64;
    LAS float* Bbr = pwi + 17 * 64;
    LAS float* Bbi = Bbr + 1024;
    LAS float* Cr = Bbi + 1024;
    LAS float* Ci = Cr + 1024;
    LAS float* Kt = Ci + 1024;
    LAS float* cf = Kt + 4096;
    const float dt = __expf(a.in[I_LDT][g]);
    if (tid < 64) {
        const int p = tid; const float lr = a.in[I_LRE][g * 64 + p], li = a.in[I_LIM][g * 64 + p];
        const float th = li * dt;
        const float rev = th * 0.15915494309189535f;
#pragma unroll 1
        for (int tau = 0; tau <= 16; ++tau) {
            const float mg = __expf(lr * dt * (float)tau);
            float rv = rev * (float)tau; rv = rv - rintf(rv);
            const float ang = rv * 6.283185307179586f;
            pwr[tau * 64 + p] = mg * __cosf(ang); pwi[tau * 64 + p] = mg * __sinf(ang);
        }
        const float ar = pwr[64 + p], ai = pwi[64 + p];
        const float nr = ar - 1.0f, ni = ai, den = lr * lr + li * li;
        cf[2 * p] = (nr * lr + ni * li) / den; cf[2 * p + 1] = (ni * lr - nr * li) / den;
        float2* a16 = (float2*)(a.ws + WS_A16);
        a16[g * 64 + p] = make_float2(pwr[16 * 64 + p], pwi[16 * 64 + p]);
    }
    __syncthreads();
    for (int e = tid; e < 1024; e += 512) { const int p = e >> 4; const float br = a.in[I_BRE][(size_t)g * 1024 + e], bi = a.in[I_BIM][(size_t)g * 1024 + e];
        const float cr = cf[2 * p], ci = cf[2 * p + 1]; Bbr[e] = cr * br - ci * bi; Bbi[e] = cr * bi + ci * br;
        Cr[e] = a.in[I_CRE][(size_t)g * 1024 + e]; Ci[e] = a.in[I_CIM][(size_t)g * 1024 + e]; }
    __syncthreads();
    for (int e = tid; e < 4096; e += 512) { const int tau = e >> 8, co = (e >> 4) & 15, ci = e & 15; float s = 0.f;
        for (int p = 0; p < 64; ++p) { const float mr = Cr[co * 64 + p] * pwr[tau * 64 + p] - Ci[co * 64 + p] * pwi[tau * 64 + p], mi = Cr[co * 64 + p] * pwi[tau * 64 + p] + Ci[co * 64 + p] * pwr[tau * 64 + p];
            s += mr * Bbr[p * 16 + ci] - mi * Bbi[p * 16 + ci]; }
        Kt[e] = s; }
    __syncthreads();
    bf16_t* TG = (bf16_t*)(a.ws + WS_TG) + (size_t)g * 256 * KT;
    for (int e = tid; e < 256 * KT; e += 512) { const int n = e / KT, k = e % KT, t = n >> 4, co = n & 15; float v;
        if (k < 256) { const int s = k >> 4, ci = k & 15; v = (t >= s) ? Kt[(t - s) * 256 + co * 16 + ci] : 0.f; if (t == s && co == ci) v += a.in[I_SD][g * 16 + co]; }
        else { const int q = k - 256, p = q & 63; const float mr = Cr[co * 64 + p] * pwr[(t + 1) * 64 + p] - Ci[co * 64 + p] * pwi[(t + 1) * 64 + p], mi = Cr[co * 64 + p] * pwi[(t + 1) * 64 + p] + Ci[co * 64 + p] * pwr[(t + 1) * 64 + p];
            v = (q < 64) ? mr : -mi; }
        TG[e] = (bf16_t)f2bf(v); }
    bf16_t* EB = (bf16_t*)(a.ws + WS_EB) + (size_t)g * 256 * 256;
    for (int e = tid; e < 256 * 256; e += 512) { const int n = e >> 8, k = e & 255, s = k >> 4, ci = k & 15; float v = 0.f;
        if (n < 128) { const int p = n & 63; const float wr_ = pwr[(15 - s) * 64 + p], wi_ = pwi[(15 - s) * 64 + p];
            v = (n < 64) ? (wr_ * Bbr[p * 16 + ci] - wi_ * Bbi[p * 16 + ci]) : (wr_ * Bbi[p * 16 + ci] + wi_ * Bbr[p * 16 + ci]); }
        EB[e] = (bf16_t)f2bf(v); }
    __syncthreads();
}

typedef short v4i16_t __attribute__((ext_vector_type(4)));
__device__ __forceinline__ s16x4 vtr(LAS const unsigned char* p) { return __builtin_bit_cast(s16x4, __builtin_amdgcn_ds_read_tr16_b64_v4i16((LAS v4i16_t*)p)); }
constexpr int AT_KP = 144;
constexpr int AT_VOFF = 384 * AT_KP;
constexpr int AT_NWU = 6144;
struct AttnUnitW { int d, r, h, L0; size_t rowbase; int pat; };
__device__ __forceinline__ AttnUnitW attn_decode(int wgu) {
    AttnUnitW t; t.pat = wgu >> 11; int rem = wgu & 2047; const int dsh = t.pat * 2; t.d = 1 << dsh;
    const int cg = rem & ((32 >> dsh) - 1); rem >>= (5 - dsh); t.r = rem & (t.d - 1); rem >>= dsh; t.h = rem & 15; t.rowbase = (size_t)(rem >> 4) * SEQ; t.L0 = cg * 256; return t;
}
__device__ __forceinline__ void attn_phase(const bf16_t* qkv, bf16_t* opart, float* ml, LAS unsigned char* lds, int wave, int lane, int G) {
    const int tid = threadIdx.x;
    const int i32 = lane & 31, hh = lane >> 5, g4 = lane >> 4, q4 = (lane & 15) >> 2, p4 = lane & 3;
    const int bx = blockIdx.x, vcu = (G % 8 == 0) ? (bx % 8) * (G / 8) + bx / 8 : bx;
    const int per = (AT_NWU + G - 1) / G;
    const int u0 = vcu * per, u1 = (u0 + per < AT_NWU) ? u0 + per : AT_NWU;
    if (u0 >= u1) return;
    const int skey = tid >> 3, sc = tid & 7;
    const unsigned kwoff = (unsigned)(skey * AT_KP + sc * 16), vwoff = (unsigned)(AT_VOFF + (sc >> 2) * 24576 + skey * 64 + (sc & 3) * 16);
    const unsigned krd = (unsigned)((32 * wave + i32) * AT_KP + hh * 16);
    const unsigned vrd = (unsigned)(AT_VOFF + (32 * wave + 4 * hh + q4) * 64 + (16 * (p4 & 1) + 8 * (g4 & 1) + 4 * (p4 >> 1)) * 2);
    u32x4 kreg[6], vreg[6]; bf16x8 qn[4];
    AttnUnitW cu = attn_decode(u0);
#define AT_ISSUE(t) do { const bf16_t* hb = qkv + ((t).rowbase * 16 + (size_t)(t).h * SEQ) * 64;     \
        _Pragma("unroll") for (int i = 0; i < 6; ++i) { int lk = (t).L0 - 128 + skey + 64 * i; lk = lk < 0 ? 0 : lk; \
            const bf16_t* gp = hb + ((size_t)lk * (t).d + (t).r) * 64 + sc * 8; kreg[i] = *(const u32x4*)(gp + (size_t)MT * AW); vreg[i] = *(const u32x4*)(gp + 2 * (size_t)MT * AW); } \
        const bf16_t* qp = hb + ((size_t)((t).L0 + 32 * wave + i32) * (t).d + (t).r) * 64 + hh * 8; \
        _Pragma("unroll") for (int ks = 0; ks < 4; ++ks) qn[ks] = *(const bf16x8*)(qp + ks * 16); } while (0)
    AT_ISSUE(cu);
    for (int u = u0; u < u1; ++u) {
#pragma unroll
        for (int i = 0; i < 6; ++i) { *(LAS u32x4*)(lds + kwoff + i * 64 * AT_KP) = kreg[i]; *(LAS u32x4*)(lds + vwoff + i * 64 * 64) = vreg[i]; }
        bf16x8 q[4];
#pragma unroll
        for (int ks = 0; ks < 4; ++ks) q[ks] = qn[ks];
        const AttnUnitW t = cu;
        __syncthreads();
        if (u + 1 < u1) { cu = attn_decode(u + 1); AT_ISSUE(cu); }
        const int l0 = t.L0 + 32 * wave;
        f32x16 st[5];
#pragma unroll
        for (int kt = 0; kt < 5; ++kt) {
            bf16x8 kf[4];
#pragma unroll
            for (int ks = 0; ks < 4; ++ks) kf[ks] = *(const LAS bf16x8*)(lds + krd + kt * 32 * AT_KP + ks * 32);
            f32x16 acc;
#pragma unroll
            for (int v = 0; v < 16; ++v) acc[v] = 0.f;
#pragma unroll
            for (int ks = 0; ks < 4; ++ks) acc = __builtin_amdgcn_mfma_f32_32x32x16_bf16(kf[ks], q[ks], acc, 0, 0, 0);
            st[kt] = acc;
        }
#pragma unroll
        for (int v = 0; v < 16; ++v) { const int j = (v & 3) + 8 * (v >> 2) + 4 * hh; if (j < i32) st[0][v] = -1e30f; if (j > i32) st[4][v] = -1e30f; }
        if (l0 < 128) {
#pragma unroll
            for (int kt = 0; kt < 4; ++kt)
#pragma unroll
                for (int v = 0; v < 16; ++v) { const int j = (v & 3) + 8 * (v >> 2) + 4 * hh; if (l0 - 128 + 32 * kt + j < 0) st[kt][v] = -1e30f; }
        }
        float mx = -1e30f;
#pragma unroll
        for (int kt = 0; kt < 5; ++kt)
#pragma unroll
            for (int v = 0; v < 16; v += 2) mx = fmaxf(mx, fmaxf(st[kt][v], st[kt][v + 1]));
        mx = fmaxf(mx, __shfl_xor(mx, 32));
        const float C = 0.125f * 1.4426950408889634f, mC = mx * C;
        float sum = 0.f;
#pragma unroll
        for (int kt = 0; kt < 5; ++kt)
#pragma unroll
            for (int v = 0; v < 16; ++v) { const float p = __builtin_amdgcn_exp2f(st[kt][v] * C - mC); st[kt][v] = p; sum += p; }
        sum += __shfl_xor(sum, 32);
        f32x16 o0, o1;
#pragma unroll
        for (int v = 0; v < 16; ++v) { o0[v] = 0.f; o1[v] = 0.f; }
#pragma unroll
        for (int kt = 0; kt < 5; ++kt)
#pragma unroll
            for (int s2 = 0; s2 < 2; ++s2) {
                bf16x8 pb; { unsigned w0 = pg8::cvt_pk_bf16(st[kt][8 * s2 + 0], st[kt][8 * s2 + 1]), w1 = pg8::cvt_pk_bf16(st[kt][8 * s2 + 2], st[kt][8 * s2 + 3]),
                                      w2 = pg8::cvt_pk_bf16(st[kt][8 * s2 + 4], st[kt][8 * s2 + 5]), w3 = pg8::cvt_pk_bf16(st[kt][8 * s2 + 6], st[kt][8 * s2 + 7]);
                             u32x4 ww = {w0, w1, w2, w3}; pb = __builtin_bit_cast(bf16x8, ww); }
#pragma unroll
                for (int dt = 0; dt < 2; ++dt) {
                    const s16x4 lo = vtr(lds + vrd + dt * 24576 + (kt * 32 + s2 * 16) * 64), hi = vtr(lds + vrd + dt * 24576 + (kt * 32 + s2 * 16 + 8) * 64);
                    bf16x8 av; av[0] = lo[0]; av[1] = lo[1]; av[2] = lo[2]; av[3] = lo[3]; av[4] = hi[0]; av[5] = hi[1]; av[6] = hi[2]; av[7] = hi[3];
                    if (dt == 0) o0 = __builtin_amdgcn_mfma_f32_32x32x16_bf16(av, pb, o0, 0, 0, 0); else o1 = __builtin_amdgcn_mfma_f32_32x32x16_bf16(av, pb, o1, 0, 0, 0);
                }
            }
        const float inv = 1.0f / sum; const size_t tok = t.rowbase + (size_t)(l0 + i32) * t.d + t.r;
        bf16_t* op = opart + ((size_t)t.pat * MT + tok) * AW + t.h * 64 + 16 * hh;
#pragma unroll
        for (int hv = 0; hv < 2; ++hv) {
            u32x4 w; w.x = pg8::cvt_pk_bf16(o0[8 * hv] * inv, o0[8 * hv + 1] * inv); w.y = pg8::cvt_pk_bf16(o0[8 * hv + 2] * inv, o0[8 * hv + 3] * inv);
            w.z = pg8::cvt_pk_bf16(o0[8 * hv + 4] * inv, o0[8 * hv + 5] * inv); w.w = pg8::cvt_pk_bf16(o0[8 * hv + 6] * inv, o0[8 * hv + 7] * inv); *(u32x4*)(op + 8 * hv) = w;
            u32x4 w2; w2.x = pg8::cvt_pk_bf16(o1[8 * hv] * inv, o1[8 * hv + 1] * inv); w2.y = pg8::cvt_pk_bf16(o1[8 * hv + 2] * inv, o1[8 * hv + 3] * inv);
            w2.z = pg8::cvt_pk_bf16(o1[8 * hv + 4] * inv, o1[8 * hv + 5] * inv); w2.w = pg8::cvt_pk_bf16(o1[8 * hv + 6] * inv, o1[8 * hv + 7] * inv); *(u32x4*)(op + 32 + 8 * hv) = w2;
        }
        if (hh == 0) *(f32x2*)(ml + (((size_t)t.pat * MT + tok) * 16 + t.h) * 2) = (f32x2){mx * 0.125f, sum};
        __syncthreads();
    }
#undef AT_ISSUE
}

__device__ __forceinline__ void combine_row(const bf16_t* opart, const float* ml, const bf16_t* yb, const float* ga, const float* gb, bf16_t* Y, size_t row, int lane) {
    const int head = lane >> 2;
    float m[3], l[3];
#pragma unroll
    for (int p = 0; p < 3; ++p) { const f32x2 v = *(const f32x2*)(ml + (((size_t)p * MT + row) * 16 + head) * 2); m[p] = v[0]; l[p] = v[1]; }
    const float mg = fmaxf(m[0], fmaxf(m[1], m[2]));
    float w[3], den = 0.f;
#pragma unroll
    for (int p = 0; p < 3; ++p) { w[p] = __expf(m[p] - mg) * l[p]; den += w[p]; }
    const float iden = 1.0f / den;
    float ya[16];
#pragma unroll
    for (int e = 0; e < 16; ++e) ya[e] = 0.f;
#pragma unroll
    for (int p = 0; p < 3; ++p) { const u32x4* src = (const u32x4*)(opart + ((size_t)p * MT + row) * AW + lane * 16); const float wp = w[p] * iden;
#pragma unroll
        for (int hv = 0; hv < 2; ++hv) { const u32x4 x = src[hv];
            ya[8 * hv + 0] += wp * bflo(x.x); ya[8 * hv + 1] += wp * bfhi(x.x); ya[8 * hv + 2] += wp * bflo(x.y); ya[8 * hv + 3] += wp * bfhi(x.y);
            ya[8 * hv + 4] += wp * bflo(x.z); ya[8 * hv + 5] += wp * bfhi(x.z); ya[8 * hv + 6] += wp * bflo(x.w); ya[8 * hv + 7] += wp * bfhi(x.w); } }
    float s = 0.f;
#pragma unroll
    for (int e = 0; e < 16; ++e) s += ya[e] * ya[e];
    float rstd = rsqrtf(wave_sum(s) * (1.f / AW) + EPS);
    {   u32x4 o[2];
#pragma unroll
        for (int hv = 0; hv < 2; ++hv) { const f32x4 g0 = *(const f32x4*)(ga + lane * 16 + 8 * hv), g1 = *(const f32x4*)(ga + lane * 16 + 8 * hv + 4);
            o[hv].x = pk2(ya[8 * hv] * rstd * g0[0], ya[8 * hv + 1] * rstd * g0[1]); o[hv].y = pk2(ya[8 * hv + 2] * rstd * g0[2], ya[8 * hv + 3] * rstd * g0[3]);
            o[hv].z = pk2(ya[8 * hv + 4] * rstd * g1[0], ya[8 * hv + 5] * rstd * g1[1]); o[hv].w = pk2(ya[8 * hv + 6] * rstd * g1[2], ya[8 * hv + 7] * rstd * g1[3]); }
        u32x4* dst = (u32x4*)(Y + row * DM + lane * 16); dst[0] = o[0]; dst[1] = o[1]; }
    float yv[16];
    { const u32x4* src = (const u32x4*)(yb + row * SW + lane * 16);
#pragma unroll
        for (int hv = 0; hv < 2; ++hv) { const u32x4 x = src[hv];
            yv[8 * hv + 0] = bflo(x.x); yv[8 * hv + 1] = bfhi(x.x); yv[8 * hv + 2] = bflo(x.y); yv[8 * hv + 3] = bfhi(x.y);
            yv[8 * hv + 4] = bflo(x.z); yv[8 * hv + 5] = bfhi(x.z); yv[8 * hv + 6] = bflo(x.w); yv[8 * hv + 7] = bfhi(x.w); } }
    s = 0.f;
#pragma unroll
    for (int e = 0; e < 16; ++e) s += yv[e] * yv[e];
    rstd = rsqrtf(wave_sum(s) * (1.f / SW) + EPS);
    {   u32x4 o[2];
#pragma unroll
        for (int hv = 0; hv < 2; ++hv) { const f32x4 g0 = *(const f32x4*)(gb + lane * 16 + 8 * hv), g1 = *(const f32x4*)(gb + lane * 16 + 8 * hv + 4);
            o[hv].x = pk2(yv[8 * hv] * rstd * g0[0], yv[8 * hv + 1] * rstd * g0[1]); o[hv].y = pk2(yv[8 * hv + 2] * rstd * g0[2], yv[8 * hv + 3] * rstd * g0[3]);
            o[hv].z = pk2(yv[8 * hv + 4] * rstd * g1[0], yv[8 * hv + 5] * rstd * g1[1]); o[hv].w = pk2(yv[8 * hv + 6] * rstd * g1[2], yv[8 * hv + 7] * rstd * g1[3]); }
        u32x4* dst = (u32x4*)(Y + row * DM + AW + lane * 16); dst[0] = o[0]; dst[1] = o[1]; }
}

__global__ void __launch_bounds__(512, 2) fwd_mega(Args a) {
    extern __shared__ __attribute__((aligned(16))) unsigned char lds_raw[];
    LAS unsigned char* lds = (LAS unsigned char*)lds_raw;
    cg::grid_group grid = cg::this_grid();
    const int tid = threadIdx.x, lane = tid & 63, wave = __builtin_amdgcn_readfirstlane(tid >> 6);
    const int G = gridDim.x, bx = blockIdx.x;
    const int gw = bx * 8 + wave, NGW = G * 8;
    unsigned char* ws = a.ws;
    bf16_t* H4 = (bf16_t*)(ws + WS_BIG);
    bf16_t* U = (bf16_t*)(ws + WS_U);
    float* ss_mix = (float*)(ws + WS_SS), *ss_f2 = ss_mix + MT, *ss_ple = ss_f2 + MT;
    volatile LAS unsigned* bst = (volatile LAS unsigned*)(lds + LDS_BYTES - 64);
    if (tid < 2) bst[tid] = 0u;
    if (bx == 0) for (int i = tid; i < XCD_BAR_WORDS; i += 512) __hip_atomic_store((unsigned*)(ws + WS_BAR) + i, 0u, __ATOMIC_RELAXED, __HIP_MEMORY_SCOPE_AGENT);

    for (int i = bx * 512 + tid; i < 3 * MT; i += G * 512) ss_mix[i] = 0.f;
    if (bx < SG) ssm_precompute(a, bx, lds, tid);
    {
        LAS float* scr = (LAS float*)(lds + wave * 16640);
        transpose_set<0>(a, scr, gw, NGW, lane);
        if (G != 256) transpose_set<1>(a, scr, gw, NGW, lane);
        { const f32x4* src = (const f32x4*)a.in[I_P]; u32x2* dst = (u32x2*)(ws + WS_PBF); const size_t n4 = (size_t)MT * PLE / 4;
          for (size_t i = (size_t)bx * 512 + tid; i < n4; i += (size_t)G * 512) { const f32x4 v = src[i]; u32x2 w; w.x = pk2(v[0], v[1]); w.y = pk2(v[2], v[3]); dst[i] = w; } }
        for (int m = gw; m < MT; m += 2 * NGW) rms_row2_bf16(a.in[I_X] + (size_t)m * DM, a.in[I_X] + (size_t)(m + NGW) * DM, a.in[I_F1N], U + (size_t)m * DM, U + (size_t)(m + NGW) * DM, lane);
    }
    grid.sync();
    const XcdBarrier bar = xcd_barrier_post((unsigned*)(ws + WS_BAR), bst);
#define SEAM() xcd_barrier(bar)

    pg8::StaticOrder S;
    { pg8::Gemm g{U, (const bf16_t*)(ws + WS_GU1), DM, DM, DM}; S.init(MT / 256, NGU / 256, G, bx, 0);
      pg8::EpiSwiGLU E{(bf16_t*)(ws + WS_HID), nullptr}; pg8::gemm_phase(lds, g, S, E); }
    if (G == 256 && bx >= 128) {
        transpose_set<1>(a, (LAS float*)(lds + wave * 16640), (bx - 128) * 8 + wave, 1024, lane); __syncthreads(); }
    SEAM();
    { pg8::Gemm g{(const bf16_t*)(ws + WS_HID), (const bf16_t*)(ws + WS_DN1), FF, FF, FF}; S.init(MT / 256, DM / 256, G, bx, 0, 4);
      pg8::EpiResid<true> E{a.in[I_X], U, ss_mix, 0.5f, (LAS float*)(lds + 131072)}; pg8::gemm_phase(lds, g, S, E); }
    SEAM();
    { pg8::Gemm g{U, (const bf16_t*)(ws + WS_WIN), DM, DM, DM}; S.init(MT / 256, NIN / 256, G, bx, 0);
      pg8::EpiWin E{(bf16_t*)(ws + WS_QKV), (bf16_t*)(ws + WS_ASSM), ss_mix}; pg8::gemm_phase(lds, g, S, E); }
    SEAM();
    { pg8::Gemm g{(const bf16_t*)(ws + WS_ASSM), (const bf16_t*)(ws + WS_EB), KT, 256, 256}; S.init(SG * ROWS_G / 256, 1, G, bx, ROWS_G / 256);
      pg8::EpiE E{(float*)(ws + WS_E)}; pg8::gemm_phase(lds, g, S, E); }
    __syncthreads();
    attn_phase((const bf16_t*)(ws + WS_QKV), (bf16_t*)(ws + WS_OP), (float*)(ws + WS_ML), lds, wave, lane, G);
    SEAM();
    if (wave == 0 && bx < SG * 4) {
        const int g = bx >> 2, b = bx & 3, p = lane;
        const float2 a16 = ((const float2*)(ws + WS_A16))[g * 64 + p];
        const float* Eb = (const float*)(ws + WS_E) + ((size_t)g * ROWS_G + b * NCH) * 128;
        bf16_t* As = (bf16_t*)(ws + WS_ASSM) + ((size_t)g * ROWS_G + b * NCH) * KT + 256;
        float hr = 0.f, hi = 0.f;
        for (int c0 = 0; c0 < NCH; c0 += 16) {
            float er[16], ei[16];
#pragma unroll
            for (int j = 0; j < 16; ++j) { er[j] = Eb[(size_t)(c0 + j) * 128 + p]; ei[j] = Eb[(size_t)(c0 + j) * 128 + 64 + p]; }
#pragma unroll
            for (int j = 0; j < 16; ++j) { As[(size_t)(c0 + j) * KT + p] = (bf16_t)f2bf(hr); As[(size_t)(c0 + j) * KT + 64 + p] = (bf16_t)f2bf(hi);
                const float nr = a16.x * hr - a16.y * hi + er[j], ni = a16.x * hi + a16.y * hr + ei[j]; hr = nr; hi = ni; }
        }
    }
    SEAM();
    { pg8::Gemm g{(const bf16_t*)(ws + WS_ASSM), (const bf16_t*)(ws + WS_TG), KT, KT, KT}; S.init(SG * ROWS_G / 256, 1, G, bx, ROWS_G / 256);
      pg8::EpiToep E{(bf16_t*)(ws + WS_E)}; pg8::gemm_phase(lds, g, S, E); }
    SEAM();
    { pg8::Gemm g{(const bf16_t*)(ws + WS_E), (const bf16_t*)(ws + WS_WGLU), SW, SW, SW}; S.init(MT / 256, SW / 256, G, bx, 0);
      pg8::EpiGLU E{(const bf16_t*)(ws + WS_E), a.in[I_BGLU], (bf16_t*)(ws + WS_ASSM)}; pg8::gemm_phase(lds, g, S, E); }
    SEAM();
    for (int m = gw; m < MT; m += NGW) combine_row((const bf16_t*)(ws + WS_OP), (const float*)(ws + WS_ML), (const bf16_t*)(ws + WS_ASSM), a.in[I_AON], a.in[I_SON], (bf16_t*)(ws + WS_Y), (size_t)m, lane);
    SEAM();
    { pg8::Gemm g{(const bf16_t*)(ws + WS_Y), (const bf16_t*)(ws + WS_WOUT), DM, DM, DM}; S.init(MT / 256, DM / 256, G, bx, 0, 4);
      pg8::EpiResid<false> E{nullptr, U, ss_f2, 1.0f, (LAS float*)(lds + 131072)}; pg8::gemm_phase(lds, g, S, E); }
    SEAM();
    { pg8::Gemm g{U, (const bf16_t*)(ws + WS_GU2), DM, DM, DM}; S.init(MT / 256, NGU / 256, G, bx, 0);
      pg8::EpiSwiGLU E{(bf16_t*)(ws + WS_HID), ss_f2}; pg8::gemm_phase(lds, g, S, E); }
    {
      const bool tail_fill = (G == 256); pg8::Gemm g{(const bf16_t*)(ws + WS_PBF), (const bf16_t*)(ws + WS_WPLE), PLE, PLE, PLE};
      if (tail_fill) S.init(MT / 256, DM / 256, 128, bx - 128, 0); else S.init(MT / 256, DM / 256, G, bx, 0, 4);
      pg8::EpiBf16 E{(bf16_t*)(ws + WS_PP), DM}; if (!tail_fill || bx >= 128) pg8::gemm_phase(lds, g, S, E); }
    SEAM();
    { pg8::Gemm g{(const bf16_t*)(ws + WS_HID), (const bf16_t*)(ws + WS_DN2), FF, FF, FF}; S.init(MT / 256, DM / 256, G, bx, 0, 4);
      pg8::EpiResid<false> E{nullptr, U, ss_ple, 0.5f, (LAS float*)(lds + 131072)}; pg8::gemm_phase(lds, g, S, E); }
    SEAM();
    { pg8::Gemm g{U, (const bf16_t*)(ws + WS_WPG), DM, DM, DM}; S.init(MT / 256, DM / 256, G, bx, 0, 4);
      pg8::EpiPleGate E{H4, U, (const bf16_t*)(ws + WS_PP), ss_ple}; pg8::gemm_phase(lds, g, S, E); }
    SEAM();
    for (int m = gw; m < MT; m += 2 * NGW) rms_row2_out(H4 + (size_t)m * DM, H4 + (size_t)(m + NGW) * DM, a.out + (size_t)m * DM, a.out + (size_t)(m + NGW) * DM, a.in[I_FINN], lane);
}

extern "C" void kernel_launch(void* const* d_in, const int* in_sizes, int n_in, void* d_out, int out_size, void* d_ws, size_t ws_size, hipStream_t stream) {
    static int grid = 0;
    if (grid == 0) {
        if (n_in != 29 || out_size != MT * DM || ws_size < WS_END) { fprintf(stderr, "kernel_launch: unexpected problem (n_in %d out %d ws %zu need %zu)\n", n_in, out_size, ws_size, (size_t)WS_END); grid = -1; return; }
        int dev = 0, cus = 0, per_cu = 0;
        (void)hipGetDevice(&dev);
        (void)hipDeviceGetAttribute(&cus, hipDeviceAttributeMultiprocessorCount, dev);
        (void)hipFuncSetAttribute((const void*)fwd_mega, hipFuncAttributeMaxDynamicSharedMemorySize, LDS_BYTES);
        (void)hipOccupancyMaxActiveBlocksPerMultiprocessor(&per_cu, (const void*)fwd_mega, 512, LDS_BYTES);
        (void)hipGetLastError();
        grid = cus;
        fprintf(stderr, "kernel_launch: cus %d per_cu %d grid %d ws %zu need %zu\n", cus, per_cu, grid, ws_size, (size_t)WS_END);
    }
    if (grid < 0) return;
    Args a{};
    for (int i = 0; i < 29; ++i) a.in[i] = (const float*)d_in[i];
    a.out = (float*)d_out; a.ws = (unsigned char*)d_ws;
    void* args[] = {&a};
    hipError_t e = hipLaunchCooperativeKernel((const void*)fwd_mega, dim3(grid), dim3(512), args, LDS_BYTES, stream);
    if (e != hipSuccess) fprintf(stderr, "kernel_launch: cooperative launch failed: %s\n", hipGetErrorString(e));
}
```

```cpp
#include <hip/hip_runtime.h>
#include <hip/hip_cooperative_groups.h>
#include <cstdio>
#include <cstdint>
namespace cg = cooperative_groups;

#define LAS __attribute__((address_space(3)))
typedef unsigned short bf16_t;
typedef short bf16x8 __attribute__((ext_vector_type(8)));
typedef short s16x4 __attribute__((ext_vector_type(4)));
typedef float f32x4 __attribute__((ext_vector_type(4)));
typedef float f32x2 __attribute__((ext_vector_type(2)));
typedef float f32x16 __attribute__((ext_vector_type(16)));
typedef unsigned u32x4 __attribute__((ext_vector_type(4)));
typedef unsigned u32x2 __attribute__((ext_vector_type(2)));

constexpr int SEQ = 8192, DM = 2048, MT = 32768, FF = 5504, NGU = 2 * FF, NIN = 4096, AW = 1024, SW = 1024, PLE = 256;
constexpr int SG = 64, SP = 64, SC = 16, LC = 16, NCH = SEQ / LC, ROWS_G = 4 * NCH  , KT = 384;
constexpr float EPS = 1e-6f;

constexpr size_t MiB = 1u << 20;
constexpr size_t al(size_t x) { return (x + MiB - 1) / MiB * MiB; }
constexpr size_t WS_GU1 = 0;
constexpr size_t WS_DN1 = WS_GU1 + al((size_t)NGU * DM * 2);
constexpr size_t WS_GU2 = WS_DN1 + al((size_t)DM * FF * 2);
constexpr size_t WS_DN2 = WS_GU2 + al((size_t)NGU * DM * 2);
constexpr size_t WS_WIN = WS_DN2 + al((size_t)DM * FF * 2);
constexpr size_t WS_WOUT = WS_WIN + al((size_t)NIN * DM * 2);
constexpr size_t WS_WPG = WS_WOUT + al((size_t)DM * DM * 2);
constexpr size_t WS_WPLE = WS_WPG + al((size_t)DM * DM * 2);
constexpr size_t WS_WGLU = WS_WPLE + al((size_t)DM * PLE * 2);
constexpr size_t WS_TG = WS_WGLU + al((size_t)SW * SW * 2);
constexpr size_t WS_EB = WS_TG + al((size_t)SG * 256 * KT * 2);
constexpr size_t WS_PBF = WS_EB + al((size_t)SG * 256 * 256 * 2);
constexpr size_t WS_A16 = WS_PBF + al((size_t)MT * PLE * 2);
constexpr size_t WS_BAR = WS_A16 + 65536;
constexpr size_t WS_SS = WS_A16 + 131072;
constexpr size_t WS_U = WS_A16 + MiB;
constexpr size_t WS_BIG = WS_U + al((size_t)MT * DM * 2);
constexpr size_t WS_HID = WS_BIG;
constexpr size_t WS_QKV = WS_BIG;
constexpr size_t WS_ASSM = WS_QKV + al((size_t)MT * 3072 * 2);
constexpr size_t WS_E = WS_ASSM + al((size_t)SG * ROWS_G * KT * 2);
constexpr size_t WS_OP = WS_E + al((size_t)SG * ROWS_G * 128 * 4);
constexpr size_t WS_ML = WS_OP + al((size_t)3 * MT * AW * 2);
constexpr size_t WS_MIXEND = WS_ML + al((size_t)3 * MT * 16 * 2 * 4);
constexpr size_t WS_Y = WS_BIG;
constexpr size_t WS_PP = WS_BIG + 384 * MiB;
constexpr size_t WS_END = (WS_MIXEND > WS_HID + al((size_t)MT * FF * 2)) ? WS_MIXEND : WS_HID + al((size_t)MT * FF * 2);
static_assert(WS_END <= (size_t)1024 * MiB && WS_PP >= WS_HID + (size_t)MT * FF * 2 && WS_PP + (size_t)MT * DM * 2 <= WS_END && WS_SS + 3 * MT * 4 <= WS_U, "workspace map");

constexpr int LDS_BYTES = 147456;

__device__ __forceinline__ unsigned f2bf(float f) { unsigned u = __builtin_bit_cast(unsigned, f); return (u + 0x7fffu + ((u >> 16) & 1u)) >> 16; }
__device__ __forceinline__ unsigned pk2(float lo, float hi) { return f2bf(lo) | (f2bf(hi) << 16); }
__device__ __forceinline__ float bflo(unsigned w) { return __builtin_bit_cast(float, w << 16); }
__device__ __forceinline__ float bfhi(unsigned w) { return __builtin_bit_cast(float, w & 0xffff0000u); }
__device__ __forceinline__ float fsigmoid(float x) { return __builtin_amdgcn_rcpf(1.0f + __expf(-x)); }
__device__ __forceinline__ float gelu_tanh(float x) { const float u = 1.5957691216057308f * (x + 0.044715f * x * x * x); return x * fsigmoid(u); }
__device__ __forceinline__ float wave_sum(float v) {
#pragma unroll
    for (int o = 1; o < 64; o <<= 1) v += __shfl_xor(v, o);
    return v;
}

namespace pg8 {
constexpr int BM = 256, BK = 64, HALF = 128, HTB = HALF * BK * 2, STAGE_BYTES = 8 * HTB, NXCD = 8, WGM = 4;
__host__ __device__ __forceinline__ int lds_byte(int r, int c) { const int st = (r >> 4) * 2 + (c >> 5), rr = r & 15, cc = c & 31, ob = rr * 64 + cc * 2; return st * 1024 + (ob ^ (((ob >> 9) & 1) << 5)); }
__host__ __device__ __forceinline__ void stage_rc(int b, int& R, int& C) { const int st = b / 1024, sb = b % 1024, swz = sb ^ (((sb >> 9) & 1) << 5); R = (st >> 1) * 16 + swz / 64; C = (st & 1) * 32 + (swz % 64) / 2; }
__host__ __device__ __forceinline__ int perm32(int rho) { const int n = rho >> 4, i = rho & 15; return 8 * (i >> 2) + 4 * n + (i & 3); }

struct Unit { int pm, pn, pb; };
struct Gemm { const bf16_t* A; const bf16_t* Bt; int lda, ldb, K; };

struct StaticOrder {
    int nM, nN, nwg, G, c, bdiv, wgm;
    __device__ void init(int nM_, int nN_, int G_, int c_, int bdiv_, int wgm_ = WGM) { nM = nM_; nN = nN_; nwg = nM * nN; G = G_; c = c_; bdiv = bdiv_; wgm = wgm_; }
    __device__ bool next(int i, Unit& u) const {
        const long L = (long)i * G + c; if (L >= nwg) return false;
        int wgid = (int)L; { const int q = nwg / NXCD, r = nwg % NXCD, xcd = wgid % NXCD, off = wgid / NXCD; wgid = (xcd < r ? xcd * (q + 1) : r * (q + 1) + (xcd - r) * q) + off; }
        const int nig = wgm * nN, gid = wgid / nig, fm = gid * wgm, gsz = (nM - fm) < wgm ? (nM - fm) : wgm;
        u.pm = fm + ((wgid % nig) % gsz); u.pn = (wgid % nig) / gsz; u.pb = bdiv ? (u.pm / bdiv) : u.pn; return true;
    }
};

__device__ __forceinline__ unsigned cvt_pk_bf16(float lo, float hi) { unsigned r; asm volatile("v_cvt_pk_bf16_f32 %0, %1, %2" : "=v"(r) : "v"(lo), "v"(hi)); return r; }

template <class Epi>
__device__ __forceinline__ void gemm_phase(LAS unsigned char* lds, const Gemm g, const StaticOrder& S, const Epi& E) {
    int tid_ = threadIdx.x; asm volatile("" : "+v"(tid_));
    const int tid = tid_, wid = __builtin_amdgcn_readfirstlane(tid >> 6), lane = tid & 63, wr = wid >> 2, wc = wid & 3, fr = lane & 15, fq = lane >> 4;
    int K_ = g.K; asm volatile("" : "+s"(K_));
    const int K = K_, nt = K / BK;
    unsigned voffA[2], voffB[2];
#pragma unroll
    for (int i = 0; i < 2; ++i) { int R, C; stage_rc(tid * 16 + i * 8192, R, C); const int Rb = Epi::PERM ? ((R & ~31) + perm32(R & 31)) : R;
        voffA[i] = (unsigned)(R * g.lda + C) * 2u; voffB[i] = (unsigned)(Rb * g.ldb + C) * 2u; }
    const size_t kstep = (size_t)(BK * 2);
    const size_t hstepA = (size_t)HALF * g.lda * 2, hstepB = (size_t)HALF * g.ldb * 2;
    const size_t tstepA = 2 * hstepA, tstepB = 2 * hstepB;
    const unsigned ldsw = (unsigned)wid * 1024u;
    const int aoff = lds_byte(wr * 64 + fr, fq * 8), boff = lds_byte(wc * 32 + fr, fq * 8);
#define PG8_SA(b, h) (((b) * 2 + (h)) * HTB)
#define PG8_SB(b, h) ((4 + (b) * 2 + (h)) * HTB)
#define PG8_STAGE(bufoff, gbase, voff) do { _Pragma("unroll") for (int _i = 0; _i < 2; ++_i) \
        __builtin_amdgcn_global_load_lds((const unsigned*)((const char*)(gbase) + (voff)[_i]), (LAS unsigned*)(lds + (bufoff) + ldsw + _i * 8192), 16, 0, 0); } while (0)
#define PG8_LDA(dst, b, h) do { _Pragma("unroll") for (int m = 0; m < 4; ++m) _Pragma("unroll") for (int k = 0; k < 2; ++k) dst[m][k] = *(const LAS bf16x8*)(lds + PG8_SA(b, h) + aoff + m * 2048 + k * 1024); } while (0)
#define PG8_LDB(dst, b, h) do { _Pragma("unroll") for (int n = 0; n < 2; ++n) _Pragma("unroll") for (int k = 0; k < 2; ++k) dst[n][k] = *(const LAS bf16x8*)(lds + PG8_SB(b, h) + boff + n * 2048 + k * 1024); } while (0)
#define PG8_MMA(ai, bj, At, Bt) do { __builtin_amdgcn_s_setprio(1); _Pragma("unroll") for (int m = 0; m < 4; ++m) _Pragma("unroll") for (int n = 0; n < 2; ++n) _Pragma("unroll") for (int k = 0; k < 2; ++k) \
        acc[ai][bj][m][n] = __builtin_amdgcn_mfma_f32_16x16x32_bf16(Bt[n][k], At[m][k], acc[ai][bj][m][n], 0, 0, 0); __builtin_amdgcn_s_setprio(0); } while (0)
#define PG8_WAIT_V(n) asm volatile("s_waitcnt vmcnt(" #n ")" ::: "memory")
#define PG8_WAIT_L(n) asm volatile("s_waitcnt lgkmcnt(" #n ")" ::: "memory")
#define PG8_BAR __builtin_amdgcn_s_barrier()
#define PG8_SCHED __builtin_amdgcn_sched_barrier(0)
    Unit cur, nxt; int ui = 0;
    if (!S.next(0, cur)) return;
    f32x4 acc[2][2][4][2];
#pragma unroll
    for (int a = 0; a < 2; ++a)
#pragma unroll
        for (int b = 0; b < 2; ++b)
#pragma unroll
            for (int m = 0; m < 4; ++m)
#pragma unroll
                for (int n = 0; n < 2; ++n) acc[a][b][m][n] = (f32x4){0.f, 0.f, 0.f, 0.f};
    bf16x8 At[4][2], B0[2][2], B1[2][2];
    const char* cA = (const char*)g.A + (size_t)cur.pm * tstepA; const char* cB = (const char*)g.Bt + (size_t)cur.pb * tstepB;
    PG8_STAGE(PG8_SB(0, 0), cB, voffB); PG8_STAGE(PG8_SB(0, 1), cB + hstepB, voffB); PG8_STAGE(PG8_SA(0, 0), cA, voffA); PG8_STAGE(PG8_SA(0, 1), cA + hstepA, voffA);
    if (wr == 1) PG8_BAR;
    PG8_WAIT_V(2); PG8_BAR;
    PG8_STAGE(PG8_SB(1, 0), cB + kstep, voffB); PG8_STAGE(PG8_SA(1, 0), cA + kstep, voffA); PG8_STAGE(PG8_SB(1, 1), cB + hstepB + kstep, voffB);
    PG8_WAIT_V(6); PG8_BAR;
    for (;;) {
        const bool has_next = S.next(ui + 1, nxt);
        const char* nA = has_next ? (const char*)g.A + (size_t)nxt.pm * tstepA : cA; const char* nB = has_next ? (const char*)g.Bt + (size_t)nxt.pb * tstepB : cB;
        for (int t = 0; t < nt; t += 2) {
            const bool last = (t == nt - 2);
            const char* a1 = cA + (size_t)(t + 1) * kstep;
            const char* a2 = last ? nA : cA + (size_t)(t + 2) * kstep; const char* b2 = last ? nB : cB + (size_t)(t + 2) * kstep;
            const char* a3 = a2 + kstep; const char* b3 = b2 + kstep;
            PG8_LDB(B0, 0, 0); PG8_LDB(B1, 0, 1); PG8_SCHED; PG8_LDA(At, 0, 0); PG8_STAGE(PG8_SA(1, 1), a1 + hstepA, voffA);
            PG8_WAIT_V(8); PG8_WAIT_L(0); PG8_BAR; PG8_MMA(0, 0, At, B0); PG8_MMA(0, 1, At, B1); PG8_BAR; PG8_SCHED;
            PG8_LDA(At, 0, 1); PG8_STAGE(PG8_SB(0, 0), b2, voffB); PG8_STAGE(PG8_SB(0, 1), b2 + hstepB, voffB); PG8_STAGE(PG8_SA(0, 0), a2, voffA);
            PG8_WAIT_V(8); PG8_WAIT_L(0); PG8_BAR; PG8_MMA(1, 0, At, B0); PG8_MMA(1, 1, At, B1); PG8_BAR; PG8_SCHED;
            PG8_LDB(B0, 1, 0); PG8_LDB(B1, 1, 1); PG8_SCHED; PG8_LDA(At, 1, 0); PG8_STAGE(PG8_SA(0, 1), a2 + hstepA, voffA);
            PG8_WAIT_V(8); PG8_WAIT_L(0); PG8_BAR; PG8_MMA(0, 0, At, B0); PG8_MMA(0, 1, At, B1); PG8_BAR; PG8_SCHED;
            PG8_LDA(At, 1, 1); PG8_STAGE(PG8_SB(1, 0), b3, voffB); PG8_STAGE(PG8_SB(1, 1), b3 + hstepB, voffB); PG8_STAGE(PG8_SA(1, 0), a3, voffA);
            PG8_WAIT_V(8); PG8_WAIT_L(0); PG8_BAR; PG8_MMA(1, 0, At, B0); PG8_MMA(1, 1, At, B1); PG8_BAR; PG8_SCHED;
        }
        if (wr == 0) PG8_BAR;
        E(acc, cur, wr, wc, fr, fq);
        if (!has_next) break;
#pragma unroll
        for (int a = 0; a < 2; ++a)
#pragma unroll
            for (int b = 0; b < 2; ++b)
#pragma unroll
                for (int m = 0; m < 4; ++m)
#pragma unroll
                    for (int n = 0; n < 2; ++n) acc[a][b][m][n] = (f32x4){0.f, 0.f, 0.f, 0.f};
        cur = nxt; cA = nA; cB = nB; ++ui;
        if (wr == 1) PG8_BAR;
    }
    PG8_WAIT_V(0);
    PG8_BAR;
#undef PG8_SA
#undef PG8_SB
#undef PG8_STAGE
#undef PG8_LDA
#undef PG8_LDB
#undef PG8_MMA
#undef PG8_WAIT_V
#undef PG8_WAIT_L
#undef PG8_BAR
#undef PG8_SCHED
}

typedef f32x4 Acc[2][2][4][2];
template <bool HAS_RS> struct EpiSwiGLU {
    static constexpr bool PERM = true;
    bf16_t* H; const float* ss;
    mutable float c0[2][4], c1[2][4]; mutable int last_pm;
    __device__ __forceinline__ void operator()(const Acc& acc, const Unit& u, int wr, int wc, int fr, int fq) const {
        if constexpr (HAS_RS) {
            if (u.pm != last_pm) {
                float t[2][4];
#pragma unroll
                for (int ai = 0; ai < 2; ++ai)
#pragma unroll
                    for (int m = 0; m < 4; ++m) t[ai][m] = ss[(size_t)u.pm * BM + ai * HALF + wr * 64 + m * 16 + fr];
#pragma unroll
                for (int ai = 0; ai < 2; ++ai)
#pragma unroll
                    for (int m = 0; m < 4; ++m) { const float rs = rsqrtf(t[ai][m] * (1.f / DM) + EPS); c0[ai][m] = -1.4426950408889634f * rs; c1[ai][m] = rs * rs; }
                last_pm = u.pm;
            }
        }
        const int j0 = u.pn * HALF + wc * 32 + 8 * fq;
#pragma unroll
        for (int ai = 0; ai < 2; ++ai)
#pragma unroll
            for (int m = 0; m < 4; ++m) { const size_t row = (size_t)u.pm * BM + ai * HALF + wr * 64 + m * 16 + fr; float h[8];
                const float k0 = HAS_RS ? c0[ai][m] : -1.4426950408889634f, k1 = HAS_RS ? c1[ai][m] : 1.f;
#pragma unroll
                for (int n = 0; n < 2; ++n) { const f32x4 g = acc[ai][0][m][n], up = acc[ai][1][m][n];
#pragma unroll
                    for (int e = 0; e < 4; ++e) {
                        const float r = __builtin_amdgcn_rcpf(1.0f + __builtin_amdgcn_exp2f(g[e] * k0)); float p = g[e] * up[e]; if constexpr (HAS_RS) p *= k1; h[4 * n + e] = p * r; } }
                u32x4 w; w.x = cvt_pk_bf16(h[0], h[1]); w.y = cvt_pk_bf16(h[2], h[3]); w.z = cvt_pk_bf16(h[4], h[5]); w.w = cvt_pk_bf16(h[6], h[7]);
                *(u32x4*)(H + row * FF + j0) = w; }
    }
};
template <bool XBASE> struct EpiResid {
    static constexpr bool PERM = true;
    const float* basef; bf16_t* H; float* ss; float scale;
    __device__ __forceinline__ void operator()(Acc& acc, const Unit& u, int wr, int wc, int fr, int fq) const {
        const size_t off0 = ((size_t)u.pm * BM + wr * 64 + fr) * DM + u.pn * BM + wc * 32 + 8 * fq;
        u32x4 pa[2][2], pb[2][2];
#define ER_LOAD(ai, mp) _Pragma("unroll") for (int mm = 0; mm < 2; ++mm) _Pragma("unroll") for (int bj = 0; bj < 2; ++bj) { const size_t o2 = off0 + (size_t)((ai) * HALF + (2 * (mp) + mm) * 16) * DM + bj * HALF; \
            if constexpr (XBASE) { pa[mm][bj] = *(const u32x4*)(basef + o2); pb[mm][bj] = *(const u32x4*)(basef + o2 + 4); } else { pa[mm][bj] = *(const u32x4*)(H + o2); } }
#define ER_SUM(ai, mp) _Pragma("unroll") for (int mm = 0; mm < 2; ++mm) _Pragma("unroll") for (int bj = 0; bj < 2; ++bj) { f32x4 b0, b1; const u32x4 A = pa[mm][bj]; \
            if constexpr (XBASE) { b0 = __builtin_bit_cast(f32x4, A); b1 = __builtin_bit_cast(f32x4, pb[mm][bj]); } \
            else { b0 = (f32x4){bflo(A.x), bfhi(A.x), bflo(A.y), bfhi(A.y)}; b1 = (f32x4){bflo(A.z), bfhi(A.z), bflo(A.w), bfhi(A.w)}; } \
            acc[ai][bj][2 * (mp) + mm][0] = b0 + acc[ai][bj][2 * (mp) + mm][0] * scale; acc[ai][bj][2 * (mp) + mm][1] = b1 + acc[ai][bj][2 * (mp) + mm][1] * scale; }
#define ER_STORE(ai, mp) _Pragma("unroll") for (int mm = 0; mm < 2; ++mm) { const int m = 2 * (mp) + mm; const size_t o1 = off0 + (size_t)((ai) * HALF + m * 16) * DM; float part = 0.f; \
            _Pragma("unroll") for (int bj = 0; bj < 2; ++bj) { const size_t o2 = o1 + bj * HALF; const f32x4 v = acc[ai][bj][m][0], v2 = acc[ai][bj][m][1]; \
                part += ((v[0] * v[0] + v[1] * v[1]) + (v[2] * v[2] + v[3] * v[3])) + ((v2[0] * v2[0] + v2[1] * v2[1]) + (v2[2] * v2[2] + v2[3] * v2[3])); \
                u32x4 w; w.x = cvt_pk_bf16(v[0], v[1]); w.y = cvt_pk_bf16(v[2], v[3]); w.z = cvt_pk_bf16(v2[0], v2[1]); w.w = cvt_pk_bf16(v2[2], v2[3]); *(u32x4*)(H + o2) = w; } \
            part += __shfl_xor(part, 16); part += __shfl_xor(part, 32); \
            if (fq == 0) (void)__hip_atomic_fetch_add(ss + (size_t)u.pm * BM + (ai) * HALF + wr * 64 + m * 16 + fr, part, __ATOMIC_RELAXED, __HIP_MEMORY_SCOPE_AGENT); }
        ER_LOAD(0, 0) ER_SUM(0, 0) asm volatile("" ::: "memory"); ER_LOAD(0, 1) asm volatile("" ::: "memory"); ER_STORE(0, 0) ER_SUM(0, 1) asm volatile("" ::: "memory");
        ER_LOAD(1, 0) asm volatile("" ::: "memory"); ER_STORE(0, 1) ER_SUM(1, 0) asm volatile("" ::: "memory"); ER_LOAD(1, 1) asm volatile("" ::: "memory"); ER_STORE(1, 0) ER_SUM(1, 1) ER_STORE(1, 1)
#undef ER_LOAD
#undef ER_SUM
#undef ER_STORE
    }
};
struct EpiPleGate {
    static constexpr bool PERM = true;
    bf16_t* O; const bf16_t* H; const bf16_t* P; const float* ss;
    __device__ __forceinline__ void operator()(Acc& acc, const Unit& u, int wr, int wc, int fr, int fq) const {
        const size_t row0 = (size_t)u.pm * BM + wr * 64 + fr; const size_t off0 = row0 * DM + u.pn * BM + wc * 32 + 8 * fq;
        float rsv[2][4];
#pragma unroll
        for (int ai = 0; ai < 2; ++ai)
#pragma unroll
            for (int m = 0; m < 4; ++m) rsv[ai][m] = ss[row0 + ai * HALF + m * 16];
#pragma unroll
        for (int ai = 0; ai < 2; ++ai)
#pragma unroll
            for (int m = 0; m < 4; ++m) rsv[ai][m] = rsqrtf(rsv[ai][m] * (1.f / DM) + EPS);
        u32x4 ph[2][2], pp[2][2];
#define PG_LOAD(ai, mp) _Pragma("unroll") for (int mm = 0; mm < 2; ++mm) _Pragma("unroll") for (int bj = 0; bj < 2; ++bj) { \
            const size_t o2 = off0 + (size_t)((ai) * HALF + (2 * (mp) + mm) * 16) * DM + bj * HALF; ph[mm][bj] = *(const u32x4*)(H + o2); pp[mm][bj] = *(const u32x4*)(P + o2); }
#define PG_SUM(ai, mp) _Pragma("unroll") for (int mm = 0; mm < 2; ++mm) _Pragma("unroll") for (int bj = 0; bj < 2; ++bj) { const float rs = rsv[ai][2 * (mp) + mm]; const u32x4 h = ph[mm][bj], pw = pp[mm][bj]; \
            { const f32x4 a = acc[ai][bj][2 * (mp) + mm][0] * rs; f32x4 v; v[0] = bflo(h.x) + fsigmoid(a[0]) * bflo(pw.x); v[1] = bfhi(h.x) + fsigmoid(a[1]) * bfhi(pw.x); \
              v[2] = bflo(h.y) + fsigmoid(a[2]) * bflo(pw.y); v[3] = bfhi(h.y) + fsigmoid(a[3]) * bfhi(pw.y); acc[ai][bj][2 * (mp) + mm][0] = v; } \
            { const f32x4 a = acc[ai][bj][2 * (mp) + mm][1] * rs; f32x4 v; v[0] = bflo(h.z) + fsigmoid(a[0]) * bflo(pw.z); v[1] = bfhi(h.z) + fsigmoid(a[1]) * bfhi(pw.z); \
              v[2] = bflo(h.w) + fsigmoid(a[2]) * bflo(pw.w); v[3] = bfhi(h.w) + fsigmoid(a[3]) * bfhi(pw.w); acc[ai][bj][2 * (mp) + mm][1] = v; } }
#define PG_STORE(ai, mp) _Pragma("unroll") for (int mm = 0; mm < 2; ++mm) _Pragma("unroll") for (int bj = 0; bj < 2; ++bj) { const f32x4 v = acc[ai][bj][2 * (mp) + mm][0], v2 = acc[ai][bj][2 * (mp) + mm][1]; \
            u32x4 w; w.x = cvt_pk_bf16(v[0], v[1]); w.y = cvt_pk_bf16(v[2], v[3]); w.z = cvt_pk_bf16(v2[0], v2[1]); w.w = cvt_pk_bf16(v2[2], v2[3]); \
            *(u32x4*)(O + off0 + (size_t)((ai) * HALF + (2 * (mp) + mm) * 16) * DM + bj * HALF) = w; }
        PG_LOAD(0, 0) PG_SUM(0, 0) asm volatile("" ::: "memory"); PG_LOAD(0, 1) asm volatile("" ::: "memory"); PG_STORE(0, 0) PG_SUM(0, 1) asm volatile("" ::: "memory");
        PG_LOAD(1, 0) asm volatile("" ::: "memory"); PG_STORE(0, 1) PG_SUM(1, 0) asm volatile("" ::: "memory"); PG_LOAD(1, 1) asm volatile("" ::: "memory"); PG_STORE(1, 0) PG_SUM(1, 1) PG_STORE(1, 1)
#undef PG_LOAD
#undef PG_SUM
#undef PG_STORE
    }
};
struct EpiBf16 {
    static constexpr bool PERM = true;
    bf16_t* O; int ldc;
    __device__ __forceinline__ void operator()(const Acc& acc, const Unit& u, int wr, int wc, int fr, int fq) const {
#pragma unroll
        for (int ai = 0; ai < 2; ++ai)
#pragma unroll
            for (int m = 0; m < 4; ++m) { bf16_t* rowp = O + ((size_t)u.pm * BM + ai * HALF + wr * 64 + m * 16 + fr) * ldc + u.pn * BM + wc * 32 + 8 * fq;
#pragma unroll
                for (int bj = 0; bj < 2; ++bj) { const f32x4 v0 = acc[ai][bj][m][0], v1 = acc[ai][bj][m][1];
                    u32x4 w; w.x = cvt_pk_bf16(v0[0], v0[1]); w.y = cvt_pk_bf16(v0[2], v0[3]); w.z = cvt_pk_bf16(v1[0], v1[1]); w.w = cvt_pk_bf16(v1[2], v1[3]);
                    *(u32x4*)(rowp + bj * HALF) = w; } }
    }
};
struct EpiWin {
    static constexpr bool PERM = true;
    bf16_t* QKV; bf16_t* AS; const float* ss;
    __device__ __forceinline__ void operator()(const Acc& acc, const Unit& u, int wr, int wc, int fr, int fq) const {
        float rsv[2][4];
#pragma unroll
        for (int ai = 0; ai < 2; ++ai)
#pragma unroll
            for (int m = 0; m < 4; ++m) rsv[ai][m] = ss[u.pm * BM + ai * HALF + wr * 64 + m * 16 + fr];
#pragma unroll
        for (int ai = 0; ai < 2; ++ai)
#pragma unroll
            for (int m = 0; m < 4; ++m) rsv[ai][m] = rsqrtf(rsv[ai][m] * (1.f / DM) + EPS);
#pragma unroll
        for (int ai = 0; ai < 2; ++ai)
#pragma unroll
            for (int m = 0; m < 4; ++m) { const int row = u.pm * BM + ai * HALF + wr * 64 + m * 16 + fr;
                const float rs = rsv[ai][m];
#pragma unroll
                for (int bj = 0; bj < 2; ++bj) { const f32x4 v0 = acc[ai][bj][m][0] * rs, v1 = acc[ai][bj][m][1] * rs;
                    u32x4 w; w.x = cvt_pk_bf16(v0[0], v0[1]); w.y = cvt_pk_bf16(v0[2], v0[3]); w.z = cvt_pk_bf16(v1[0], v1[1]); w.w = cvt_pk_bf16(v1[2], v1[3]);
                    const int col0 = u.pn * BM + bj * HALF + wc * 32 + 8 * fq;
                    if (u.pn < 12) { const int which = col0 >> 10, hcol = col0 & 1023; *(u32x4*)(QKV + ((size_t)((which * 4 + (row >> 13)) * 16 + (hcol >> 6)) * SEQ + (row & 8191)) * 64 + (hcol & 63)) = w; }
                    else { const int ch = col0 - 3072, g = ch >> 4, c = ch & 15, b = row >> 13, t = row & 8191, chunk = t >> 4, tt = t & 15;
                        *(u32x4*)(AS + ((size_t)g * ROWS_G + b * NCH + chunk) * KT + tt * 16 + c) = w; } } }
    }
};
struct EpiE {
    static constexpr bool PERM = false;
    float* E;
    __device__ __forceinline__ void operator()(const Acc& acc, const Unit& u, int wr, int wc, int fr, int fq) const {
#pragma unroll
        for (int ai = 0; ai < 2; ++ai)
#pragma unroll
            for (int m = 0; m < 4; ++m) { float* rowp = E + ((size_t)u.pm * BM + ai * HALF + wr * 64 + m * 16 + fr) * 128 + wc * 32 + 4 * fq;
#pragma unroll
                for (int n = 0; n < 2; ++n) *(f32x4*)(rowp + n * 16) = acc[ai][0][m][n]; }
    }
};
struct EpiToep {
    static constexpr bool PERM = true;
    bf16_t* Y;
    __device__ __forceinline__ void operator()(const Acc& acc, const Unit& u, int wr, int wc, int fr, int fq) const {
#pragma unroll
        for (int ai = 0; ai < 2; ++ai)
#pragma unroll
            for (int m = 0; m < 4; ++m) { const int row = u.pm * BM + ai * HALF + wr * 64 + m * 16 + fr; const int g = row >> 11, rb = row & 2047, b = rb >> 9, chunk = rb & 511;
#pragma unroll
                for (int bj = 0; bj < 2; ++bj) { const f32x4 v0 = acc[ai][bj][m][0], v1 = acc[ai][bj][m][1];
                    u32x4 w; w.x = cvt_pk_bf16(gelu_tanh(v0[0]), gelu_tanh(v0[1])); w.y = cvt_pk_bf16(gelu_tanh(v0[2]), gelu_tanh(v0[3]));
                    w.z = cvt_pk_bf16(gelu_tanh(v1[0]), gelu_tanh(v1[1])); w.w = cvt_pk_bf16(gelu_tanh(v1[2]), gelu_tanh(v1[3]));
                    const int col0 = bj * HALF + wc * 32 + 8 * fq, tt = col0 >> 4, co = col0 & 15;
                    *(u32x4*)(Y + ((size_t)b * SEQ + chunk * LC + tt) * SW + g * 16 + co) = w; } }
    }
};
struct EpiGLU {
    static constexpr bool PERM = true;
    const bf16_t* Y; const float* bias; bf16_t* O;
    __device__ __forceinline__ void operator()(const Acc& acc, const Unit& u, int wr, int wc, int fr, int fq) const {
        const size_t off0 = ((size_t)u.pm * BM + wr * 64 + fr) * SW + u.pn * BM + wc * 32 + 8 * fq;
        f32x4 bv[2][2]; u32x4 yv[2][4][2];
#pragma unroll
        for (int bj = 0; bj < 2; ++bj) { bv[bj][0] = *(const f32x4*)(bias + u.pn * BM + bj * HALF + wc * 32 + 8 * fq); bv[bj][1] = *(const f32x4*)(bias + u.pn * BM + bj * HALF + wc * 32 + 8 * fq + 4); }
#pragma unroll
        for (int ai = 0; ai < 2; ++ai)
#pragma unroll
            for (int m = 0; m < 4; ++m)
#pragma unroll
                for (int bj = 0; bj < 2; ++bj) yv[ai][m][bj] = *(const u32x4*)(Y + off0 + (size_t)(ai * HALF + m * 16) * SW + bj * HALF);
        asm volatile("" ::: "memory");
#pragma unroll
        for (int ai = 0; ai < 2; ++ai)
#pragma unroll
            for (int m = 0; m < 4; ++m)
#pragma unroll
                for (int bj = 0; bj < 2; ++bj) { const f32x4 v0 = acc[ai][bj][m][0] + bv[bj][0], v1 = acc[ai][bj][m][1] + bv[bj][1]; const u32x4 y = yv[ai][m][bj];
                    u32x4 w; w.x = cvt_pk_bf16(bflo(y.x) * fsigmoid(v0[0]), bfhi(y.x) * fsigmoid(v0[1])); w.y = cvt_pk_bf16(bflo(y.y) * fsigmoid(v0[2]), bfhi(y.y) * fsigmoid(v0[3]));
                    w.z = cvt_pk_bf16(bflo(y.z) * fsigmoid(v1[0]), bfhi(y.z) * fsigmoid(v1[1])); w.w = cvt_pk_bf16(bflo(y.w) * fsigmoid(v1[2]), bfhi(y.w) * fsigmoid(v1[3]));
                    *(u32x4*)(O + off0 + (size_t)(ai * HALF + m * 16) * SW + bj * HALF) = w; }
    }
};
}

#define XB_TMO      128
#define XB_XCNT(j)  (256  + 64 * (j))
#define XB_XSUB(j)  (1280 + 64 * (j))
#define XB_XGEN(j)  (2304 + 64 * (j))
#define XB_TOP      3328
#define XB_TOPGEN   3392
#define XCD_BAR_WORDS 3456
#define XB_SPIN_CAP (1u << 23)
__device__ __forceinline__ unsigned xb_ld(unsigned* p)              { return __hip_atomic_load(p, __ATOMIC_RELAXED, __HIP_MEMORY_SCOPE_AGENT); }
__device__ __forceinline__ unsigned xb_add(unsigned* p, unsigned v) { return __hip_atomic_fetch_add(p, v, __ATOMIC_RELAXED, __HIP_MEMORY_SCOPE_AGENT); }
__device__ __forceinline__ unsigned xb_xcc_id() { return (unsigned)__builtin_amdgcn_s_getreg((3 << 11) | 20) & 0xFu; }
#define XB_SPIN(cond, bar) do { unsigned _sp = 0; while (cond) { __builtin_amdgcn_s_sleep(1); \
    if ((++_sp & 255u) == 0u) { if (xb_ld(&(bar)[XB_TMO])) break; if (_sp > XB_SPIN_CAP) { atomicAdd(&(bar)[XB_TMO], 1u); break; } } } } while (0)
struct XcdBarrier { unsigned* bar; unsigned x; volatile LAS unsigned* st; };
__device__ __forceinline__ XcdBarrier xcd_barrier_post(unsigned* bar, volatile LAS unsigned* st) {
    XcdBarrier b; b.bar = bar; b.x = xb_xcc_id(); b.st = st;
    if (threadIdx.x == 0) (void)xb_add(&bar[XB_XCNT(b.x)], 1u);
    return b;
}
__device__ __forceinline__ void xcd_barrier_complete(unsigned* bar, unsigned x, unsigned& nloc, unsigned& nx) {
    const unsigned G = gridDim.x * gridDim.y * gridDim.z;
    unsigned sum, cnt, mine, sp = 0u;
    for (;;) {
        sum = 0u; cnt = 0u; mine = 0u;
#pragma unroll
        for (unsigned j = 0; j < 16; ++j) { const unsigned c = xb_ld(&bar[XB_XCNT(j)]); sum += c; cnt += (c > 0u) ? 1u : 0u; mine = (j == x) ? c : mine; }
        if (sum == G) break;
        __builtin_amdgcn_s_sleep(1);
        if ((++sp & 255u) == 0u) { if (xb_ld(&bar[XB_TMO])) break; if (sp > XB_SPIN_CAP) { atomicAdd(&bar[XB_TMO], 1u); break; } }
    }
    nloc = mine > 0u ? mine : 1u; nx = cnt > 0u ? cnt : 1u;
}
__device__ __forceinline__ void xcd_barrier(const XcdBarrier& b) {
    asm volatile("s_waitcnt vmcnt(0)" ::: "memory");
    __syncthreads();
    if (threadIdx.x == 0) {
        unsigned* bar = b.bar;
        __builtin_amdgcn_s_waitcnt(0);
        unsigned nloc = b.st[0], nx = b.st[1];
        if (nloc == 0u) { xcd_barrier_complete(bar, b.x, nloc, nx); b.st[0] = nloc; b.st[1] = nx; }
        const unsigned old = xb_add(&bar[XB_XSUB(b.x)], 1u);
        const unsigned gen = old / nloc;
        if (old + 1u == (gen + 1u) * nloc) {
            __builtin_amdgcn_fence(__ATOMIC_RELEASE, "agent");
            asm volatile("s_waitcnt vmcnt(0)" ::: "memory");
            const unsigned og = xb_add(&bar[XB_TOP], 1u);
            const unsigned tg = og / nx;
            if (og + 1u == (tg + 1u) * nx) xb_add(&bar[XB_TOPGEN], 1u);
            else XB_SPIN(xb_ld(&bar[XB_TOPGEN]) == tg, bar);
            __builtin_amdgcn_fence(__ATOMIC_ACQUIRE, "agent");
            xb_add(&bar[XB_XGEN(b.x)], 1u);
            asm volatile("s_waitcnt vmcnt(0)" ::: "memory");
        } else {
            XB_SPIN(xb_ld(&bar[XB_XGEN(b.x)]) == gen, bar);
            __builtin_amdgcn_fence(__ATOMIC_ACQUIRE, "agent");
            asm volatile("s_waitcnt vmcnt(0)" ::: "memory");
        }
    }
    __syncthreads();
}

struct Args { const float* in[29]; float* out; unsigned char* ws; };
enum { I_X = 0, I_P, I_F1N, I_F1G, I_F1U, I_F1D, I_MIXN, I_WIN, I_AON, I_LRE, I_LIM, I_LDT, I_BRE, I_BIM, I_CRE, I_CIM, I_SD, I_WGLU, I_BGLU, I_SON, I_WOUT,
       I_F2N, I_F2G, I_F2U, I_F2D, I_PLN, I_WPG, I_WPLE, I_FINN };

__device__ __forceinline__ void transpose_item(const float* W, const float* gain, int K, int N, bf16_t* WT, int mode, LAS float* scr, int item, int lane) {
    const int nblk = N / 64, kb = item / nblk, nb = item % nblk, k0 = 64 * kb, n0 = 64 * nb;
    const int kl = lane >> 4, n4 = lane & 15;
    f32x4 tv[16];
#pragma unroll
    for (int i = 0; i < 16; ++i) tv[i] = *(const f32x4*)(W + (size_t)(k0 + 4 * i + kl) * N + n0 + 4 * n4);
#pragma unroll
    for (int i = 0; i < 16; ++i) { const int kk = 4 * i + kl; f32x4 v = tv[i];
        if (gain) v = v * gain[k0 + kk];
        LAS float* d = scr + kk * 65 + 4 * n4; d[0] = v[0]; d[1] = v[1]; d[2] = v[2]; d[3] = v[3]; }
    asm volatile("s_waitcnt lgkmcnt(0)" ::: "memory");
    const int c = lane & 7;
#pragma unroll
    for (int j = 0; j < 8; ++j) { const int n = (lane >> 3) + 8 * j; const LAS float* s = scr + (8 * c) * 65 + n;
        u32x4 o; o.x = pk2(s[0 * 65], s[1 * 65]); o.y = pk2(s[2 * 65], s[3 * 65]); o.z = pk2(s[4 * 65], s[5 * 65]); o.w = pk2(s[6 * 65], s[7 * 65]);
        const int ns = n0 + n; const int dr = (mode == 0) ? ns : (((ns >> 7) << 8) + (ns & 127) + (mode == 2 ? 128 : 0));
        *(u32x4*)(WT + (size_t)dr * K + k0 + 8 * c) = o; }
    asm volatile("s_waitcnt lgkmcnt(0)" ::: "memory");
}

template <int SET>
__device__ __forceinline__ void transpose_set(const Args& a, LAS float* scr, int gw, int NGW, int lane) {
    unsigned char* ws = a.ws;
    constexpr int I_GU = (DM / 64) * (FF / 64), I_DN = (FF / 64) * (DM / 64), I_IN = (DM / 64) * (NIN / 64), I_SQ = (DM / 64) * (DM / 64), I_PL = (PLE / 64) * (DM / 64), I_GL = (SW / 64) * (SW / 64);
    if constexpr (SET == 0) {
        constexpr int NITEMS = 2 * I_GU + I_DN + I_IN + I_SQ + I_GL;
        for (int it = gw; it < NITEMS; it += NGW) {
            int r = it;
            if (r < I_GU) { transpose_item(a.in[I_F1G], nullptr, DM, FF, (bf16_t*)(ws + WS_GU1), 1, scr, r, lane); continue; } r -= I_GU;
            if (r < I_GU) { transpose_item(a.in[I_F1U], nullptr, DM, FF, (bf16_t*)(ws + WS_GU1), 2, scr, r, lane); continue; } r -= I_GU;
            if (r < I_DN) { transpose_item(a.in[I_F1D], nullptr, FF, DM, (bf16_t*)(ws + WS_DN1), 0, scr, r, lane); continue; } r -= I_DN;
            if (r < I_IN) { transpose_item(a.in[I_WIN], a.in[I_MIXN], DM, NIN, (bf16_t*)(ws + WS_WIN), 0, scr, r, lane); continue; } r -= I_IN;
            if (r < I_SQ) { transpose_item(a.in[I_WOUT], nullptr, DM, DM, (bf16_t*)(ws + WS_WOUT), 0, scr, r, lane); continue; } r -= I_SQ;
            transpose_item(a.in[I_WGLU], nullptr, SW, SW, (bf16_t*)(ws + WS_WGLU), 0, scr, r, lane);
        }
    } else {
        constexpr int NITEMS = 2 * I_GU + I_DN + I_SQ + I_PL;
        for (int it = gw; it < NITEMS; it += NGW) {
            int r = it;
            if (r < I_GU) { transpose_item(a.in[I_F2G], a.in[I_F2N], DM, FF, (bf16_t*)(ws + WS_GU2), 1, scr, r, lane); continue; } r -= I_GU;
            if (r < I_GU) { transpose_item(a.in[I_F2U], a.in[I_F2N], DM, FF, (bf16_t*)(ws + WS_GU2), 2, scr, r, lane); continue; } r -= I_GU;
            if (r < I_DN) { transpose_item(a.in[I_F2D], nullptr, FF, DM, (bf16_t*)(ws + WS_DN2), 0, scr, r, lane); continue; } r -= I_DN;
            if (r < I_SQ) { transpose_item(a.in[I_WPG], a.in[I_PLN], DM, DM, (bf16_t*)(ws + WS_WPG), 0, scr, r, lane); continue; } r -= I_SQ;
            transpose_item(a.in[I_WPLE], nullptr, PLE, DM, (bf16_t*)(ws + WS_WPLE), 0, scr, r, lane);
        }
    }
}

__device__ __forceinline__ void rms_row_bf16(const float* xrow, const float* gain, bf16_t* orow, int lane) {
    const f32x4* xr = (const f32x4*)xrow + lane; const f32x4* gr = (const f32x4*)gain + lane;
    f32x4 v[8]; float s = 0.f;
#pragma unroll
    for (int j = 0; j < 8; ++j) { v[j] = xr[64 * j]; s += (v[j][0] * v[j][0] + v[j][1] * v[j][1]) + (v[j][2] * v[j][2] + v[j][3] * v[j][3]); }
    const float rstd = rsqrtf(wave_sum(s) * (1.f / DM) + EPS);
    u32x2* o8 = (u32x2*)orow + lane;
#pragma unroll
    for (int j = 0; j < 8; ++j) { const f32x4 g = gr[64 * j]; u32x2 w; w.x = pk2(v[j][0] * rstd * g[0], v[j][1] * rstd * g[1]); w.y = pk2(v[j][2] * rstd * g[2], v[j][3] * rstd * g[3]); o8[64 * j] = w; }
}
__device__ __forceinline__ void rms_row_f32(float* xrow, const float* gain, int lane) {
    f32x4* xr = (f32x4*)xrow + lane; const f32x4* gr = (const f32x4*)gain + lane;
    f32x4 v[8]; float s = 0.f;
#pragma unroll
    for (int j = 0; j < 8; ++j) { v[j] = xr[64 * j]; s += (v[j][0] * v[j][0] + v[j][1] * v[j][1]) + (v[j][2] * v[j][2] + v[j][3] * v[j][3]); }
    const float rstd = rsqrtf(wave_sum(s) * (1.f / DM) + EPS);
#pragma unroll
    for (int j = 0; j < 8; ++j) { const f32x4 g = gr[64 * j]; xr[64 * j] = v[j] * rstd * g; }
}

__device__ __forceinline__ void rms_row2_bf16(const float* x0, const float* x1, const float* gain, bf16_t* o0, bf16_t* o1, int lane) {
    const f32x4* xa = (const f32x4*)x0 + lane; const f32x4* xb = (const f32x4*)x1 + lane; const f32x4* gr = (const f32x4*)gain + lane;
    f32x4 va[8], vb[8]; float sa = 0.f, sb = 0.f;
#pragma unroll
    for (int j = 0; j < 8; ++j) va[j] = xa[64 * j];
#pragma unroll
    for (int j = 0; j < 8; ++j) vb[j] = xb[64 * j];
#pragma unroll
    for (int j = 0; j < 8; ++j) { sa += (va[j][0] * va[j][0] + va[j][1] * va[j][1]) + (va[j][2] * va[j][2] + va[j][3] * va[j][3]); sb += (vb[j][0] * vb[j][0] + vb[j][1] * vb[j][1]) + (vb[j][2] * vb[j][2] + vb[j][3] * vb[j][3]); }
    const float ra = rsqrtf(wave_sum(sa) * (1.f / DM) + EPS), rb = rsqrtf(wave_sum(sb) * (1.f / DM) + EPS);
    u32x2* pa = (u32x2*)o0 + lane; u32x2* pb = (u32x2*)o1 + lane;
#pragma unroll
    for (int j = 0; j < 8; ++j) { const f32x4 g = gr[64 * j]; u32x2 w; w.x = pk2(va[j][0] * ra * g[0], va[j][1] * ra * g[1]); w.y = pk2(va[j][2] * ra * g[2], va[j][3] * ra * g[3]); pa[64 * j] = w;
        u32x2 w2; w2.x = pk2(vb[j][0] * rb * g[0], vb[j][1] * rb * g[1]); w2.y = pk2(vb[j][2] * rb * g[2], vb[j][3] * rb * g[3]); pb[64 * j] = w2; }
}
__device__ __forceinline__ void rms_row2_out(const bf16_t* x0, const bf16_t* x1, float* y0, float* y1, const float* gain, int lane) {
    const u32x4* xa = (const u32x4*)x0 + lane; const u32x4* xb = (const u32x4*)x1 + lane;
    u32x4 ra4[4], rb4[4];
#pragma unroll
    for (int j = 0; j < 4; ++j) ra4[j] = xa[64 * j];
#pragma unroll
    for (int j = 0; j < 4; ++j) rb4[j] = xb[64 * j];
    float va[4][8], vb[4][8]; float sa = 0.f, sb = 0.f;
#pragma unroll
    for (int j = 0; j < 4; ++j) { const u32x4 A = ra4[j], B = rb4[j];
        va[j][0] = bflo(A.x); va[j][1] = bfhi(A.x); va[j][2] = bflo(A.y); va[j][3] = bfhi(A.y); va[j][4] = bflo(A.z); va[j][5] = bfhi(A.z); va[j][6] = bflo(A.w); va[j][7] = bfhi(A.w);
        vb[j][0] = bflo(B.x); vb[j][1] = bfhi(B.x); vb[j][2] = bflo(B.y); vb[j][3] = bfhi(B.y); vb[j][4] = bflo(B.z); vb[j][5] = bfhi(B.z); vb[j][6] = bflo(B.w); vb[j][7] = bfhi(B.w);
#pragma unroll
        for (int e = 0; e < 8; ++e) { sa += va[j][e] * va[j][e]; sb += vb[j][e] * vb[j][e]; } }
    const float ra = rsqrtf(wave_sum(sa) * (1.f / DM) + EPS), rb = rsqrtf(wave_sum(sb) * (1.f / DM) + EPS);
    const f32x4* gr = (const f32x4*)gain + 2 * lane; f32x4* ya = (f32x4*)y0 + 2 * lane; f32x4* yb_ = (f32x4*)y1 + 2 * lane;
#pragma unroll
    for (int j = 0; j < 4; ++j) { const f32x4 g0 = gr[128 * j], g1 = gr[128 * j + 1];
        ya[128 * j] = (f32x4){va[j][0] * ra * g0[0], va[j][1] * ra * g0[1], va[j][2] * ra * g0[2], va[j][3] * ra * g0[3]};
        ya[128 * j + 1] = (f32x4){va[j][4] * ra * g1[0], va[j][5] * ra * g1[1], va[j][6] * ra * g1[2], va[j][7] * ra * g1[3]};
        yb_[128 * j] = (f32x4){vb[j][0] * rb * g0[0], vb[j][1] * rb * g0[1], vb[j][2] * rb * g0[2], vb[j][3] * rb * g0[3]};
        yb_[128 * j + 1] = (f32x4){vb[j][4] * rb * g1[0], vb[j][5] * rb * g1[1], vb[j][6] * rb * g1[2], vb[j][7] * rb * g1[3]}; }
}

__device__ __forceinline__ void ssm_precompute(const Args& a, int g, LAS unsigned char* lds, int tid) {
    LAS float* pwr = (LAS float*)lds;
    LAS float* pwi = pwr + 17 * 64;
    LAS float* Bbr = pwi + 17 * 64;
    LAS float* Bbi = Bbr + 1024;
    LAS float* Cr = Bbi + 1024;
    LAS float* Ci = Cr + 1024;
    LAS float* Kt = Ci + 1024;
    LAS float* cf = Kt + 4096;
    const float dt = __expf(a.in[I_LDT][g]);
    if (tid < 64) {
        const int p = tid; const float lr = a.in[I_LRE][g * 64 + p], li = a.in[I_LIM][g * 64 + p];
        const float th = li * dt;
        const float rev = th * 0.15915494309189535f;
#pragma unroll 1
        for (int tau = 0; tau <= 16; ++tau) {
            const float mg = __expf(lr * dt * (float)tau);
            float rv = rev * (float)tau; rv = rv - rintf(rv);
            const float ang = rv * 6.283185307179586f;
            pwr[tau * 64 + p] = mg * __cosf(ang); pwi[tau * 64 + p] = mg * __sinf(ang);
        }
        const float ar = pwr[64 + p], ai = pwi[64 + p];
        const float nr = ar - 1.0f, ni = ai, den = lr * lr + li * li;
        cf[2 * p] = (nr * lr + ni * li) / den; cf[2 * p + 1] = (ni * lr - nr * li) / den;
        float2* a16 = (float2*)(a.ws + WS_A16);
        a16[g * 64 + p] = make_float2(pwr[16 * 64 + p], pwi[16 * 64 + p]);
    }
    __syncthreads();
    for (int e = tid; e < 1024; e += 512) { const int p = e >> 4; const float br = a.in[I_BRE][(size_t)g * 1024 + e], bi = a.in[I_BIM][(size_t)g * 1024 + e];
        const float cr = cf[2 * p], ci = cf[2 * p + 1]; Bbr[e] = cr * br - ci * bi; Bbi[e] = cr * bi + ci * br;
        Cr[e] = a.in[I_CRE][(size_t)g * 1024 + e]; Ci[e] = a.in[I_CIM][(size_t)g * 1024 + e]; }
    __syncthreads();
    for (int e = tid; e < 4096; e += 512) { const int tau = e >> 8, co = (e >> 4) & 15, ci = e & 15; float s = 0.f;
        for (int p = 0; p < 64; ++p) { const float mr = Cr[co * 64 + p] * pwr[tau * 64 + p] - Ci[co * 64 + p] * pwi[tau * 64 + p], mi = Cr[co * 64 + p] * pwi[tau * 64 + p] + Ci[co * 64 + p] * pwr[tau * 64 + p];
            s += mr * Bbr[p * 16 + ci] - mi * Bbi[p * 16 + ci]; }
        Kt[e] = s; }
    __syncthreads();
    bf16_t* TG = (bf16_t*)(a.ws + WS_TG) + (size_t)g * 256 * KT;
    for (int e = tid; e < 256 * KT; e += 512) { const int n = e / KT, k = e % KT, t = n >> 4, co = n & 15; float v;
        if (k < 256) { const int s = k >> 4, ci = k & 15; v = (t >= s) ? Kt[(t - s) * 256 + co * 16 + ci] : 0.f; if (t == s && co == ci) v += a.in[I_SD][g * 16 + co]; }
        else { const int q = k - 256, p = q & 63; const float mr = Cr[co * 64 + p] * pwr[(t + 1) * 64 + p] - Ci[co * 64 + p] * pwi[(t + 1) * 64 + p], mi = Cr[co * 64 + p] * pwi[(t + 1) * 64 + p] + Ci[co * 64 + p] * pwr[(t + 1) * 64 + p];
            v = (q < 64) ? mr : -mi; }
        TG[e] = (bf16_t)f2bf(v); }
    bf16_t* EB = (bf16_t*)(a.ws + WS_EB) + (size_t)g * 256 * 256;
    for (int e = tid; e < 256 * 256; e += 512) { const int n = e >> 8, k = e & 255, s = k >> 4, ci = k & 15; float v = 0.f;
        if (n < 128) { const int p = n & 63; const float wr_ = pwr[(15 - s) * 64 + p], wi_ = pwi[(15 - s) * 64 + p];
            v = (n < 64) ? (wr_ * Bbr[p * 16 + ci] - wi_ * Bbi[p * 16 + ci]) : (wr_ * Bbi[p * 16 + ci] + wi_ * Bbr[p * 16 + ci]); }
        EB[e] = (bf16_t)f2bf(v); }
    __syncthreads();
}

typedef short v4i16_t __attribute__((ext_vector_type(4)));
__device__ __forceinline__ s16x4 vtr(LAS const unsigned char* p) { return __builtin_bit_cast(s16x4, __builtin_amdgcn_ds_read_tr16_b64_v4i16((LAS v4i16_t*)p)); }
constexpr int AT_KP = 144;
constexpr int AT_VOFF = 384 * AT_KP;
constexpr int AT_NWU = 6144;
struct AttnUnitW { int d, r, h, L0; size_t rowbase; int pat; };
__device__ __forceinline__ AttnUnitW attn_decode(int wgu) {
    AttnUnitW t; t.pat = wgu >> 11; int rem = wgu & 2047; const int dsh = t.pat * 2; t.d = 1 << dsh;
    const int cg = rem & ((32 >> dsh) - 1); rem >>= (5 - dsh); t.r = rem & (t.d - 1); rem >>= dsh; t.h = rem & 15; t.rowbase = (size_t)(rem >> 4) * SEQ; t.L0 = cg * 256; return t;
}
__device__ __forceinline__ void attn_phase(const bf16_t* qkv, bf16_t* opart, float* ml, LAS unsigned char* lds, int wave, int lane, int G) {
    const int tid = threadIdx.x;
    const int i32 = lane & 31, hh = lane >> 5, g4 = lane >> 4, q4 = (lane & 15) >> 2, p4 = lane & 3;
    const int bx = blockIdx.x, vcu = (G % 8 == 0) ? (bx % 8) * (G / 8) + bx / 8 : bx;
    const int per = (AT_NWU + G - 1) / G;
    const int u0 = vcu * per, u1 = (u0 + per < AT_NWU) ? u0 + per : AT_NWU;
    if (u0 >= u1) return;
    const int skey = tid >> 3, sc = tid & 7;
    const unsigned kwoff = (unsigned)(skey * AT_KP + sc * 16), vwoff = (unsigned)(AT_VOFF + (sc >> 2) * 24576 + skey * 64 + (sc & 3) * 16);
    const unsigned krd = (unsigned)((32 * wave + i32) * AT_KP + hh * 16);
    const unsigned vrd = (unsigned)(AT_VOFF + (32 * wave + 4 * hh + q4) * 64 + (16 * (p4 & 1) + 8 * (g4 & 1) + 4 * (p4 >> 1)) * 2);
    u32x4 kreg[6], vreg[6]; bf16x8 qn[4];
    AttnUnitW cu = attn_decode(u0);
#define AT_ISSUE(t) do { const bf16_t* hb = qkv + ((t).rowbase * 16 + (size_t)(t).h * SEQ) * 64;     \
        _Pragma("unroll") for (int i = 0; i < 6; ++i) { int lk = (t).L0 - 128 + skey + 64 * i; lk = lk < 0 ? 0 : lk; \
            const bf16_t* gp = hb + ((size_t)lk * (t).d + (t).r) * 64 + sc * 8; kreg[i] = *(const u32x4*)(gp + (size_t)MT * AW); vreg[i] = *(const u32x4*)(gp + 2 * (size_t)MT * AW); } \
        const bf16_t* qp = hb + ((size_t)((t).L0 + 32 * wave + i32) * (t).d + (t).r) * 64 + hh * 8; \
        _Pragma("unroll") for (int ks = 0; ks < 4; ++ks) qn[ks] = *(const bf16x8*)(qp + ks * 16); } while (0)
    AT_ISSUE(cu);
    for (int u = u0; u < u1; ++u) {
#pragma unroll
        for (int i = 0; i < 6; ++i) { *(LAS u32x4*)(lds + kwoff + i * 64 * AT_KP) = kreg[i]; *(LAS u32x4*)(lds + vwoff + i * 64 * 64) = vreg[i]; }
        bf16x8 q[4];
#pragma unroll
        for (int ks = 0; ks < 4; ++ks) q[ks] = qn[ks];
        const AttnUnitW t = cu;
        __syncthreads();
        if (u + 1 < u1) { cu = attn_decode(u + 1); AT_ISSUE(cu); }
        const int l0 = t.L0 + 32 * wave;
        f32x16 st[5];
#pragma unroll
        for (int kt = 0; kt < 5; ++kt) {
            bf16x8 kf[4];
#pragma unroll
            for (int ks = 0; ks < 4; ++ks) kf[ks] = *(const LAS bf16x8*)(lds + krd + kt * 32 * AT_KP + ks * 32);
            f32x16 acc;
#pragma unroll
            for (int v = 0; v < 16; ++v) acc[v] = 0.f;
#pragma unroll
            for (int ks = 0; ks < 4; ++ks) acc = __builtin_amdgcn_mfma_f32_32x32x16_bf16(kf[ks], q[ks], acc, 0, 0, 0);
            st[kt] = acc;
        }
#pragma unroll
        for (int v = 0; v < 16; ++v) { const int j = (v & 3) + 8 * (v >> 2) + 4 * hh; if (j < i32) st[0][v] = -1e30f; if (j > i32) st[4][v] = -1e30f; }
        if (l0 < 128) {
#pragma unroll
            for (int kt = 0; kt < 4; ++kt)
#pragma unroll
                for (int v = 0; v < 16; ++v) { const int j = (v & 3) + 8 * (v >> 2) + 4 * hh; if (l0 - 128 + 32 * kt + j < 0) st[kt][v] = -1e30f; }
        }
        float mx = -1e30f;
#pragma unroll
        for (int kt = 0; kt < 5; ++kt)
#pragma unroll
            for (int v = 0; v < 16; v += 2) mx = fmaxf(mx, fmaxf(st[kt][v], st[kt][v + 1]));
        mx = fmaxf(mx, __shfl_xor(mx, 32));
        const float C = 0.125f * 1.4426950408889634f, mC = mx * C;
        float sum = 0.f;
#pragma unroll
        for (int kt = 0; kt < 5; ++kt)
#pragma unroll
            for (int v = 0; v < 16; ++v) { const float p = __builtin_amdgcn_exp2f(st[kt][v] * C - mC); st[kt][v] = p; sum += p; }
        sum += __shfl_xor(sum, 32);
        f32x16 o0, o1;
#pragma unroll
        for (int v = 0; v < 16; ++v) { o0[v] = 0.f; o1[v] = 0.f; }
#pragma unroll
        for (int kt = 0; kt < 5; ++kt)
#pragma unroll
            for (int s2 = 0; s2 < 2; ++s2) {
                bf16x8 pb; { unsigned w0 = pg8::cvt_pk_bf16(st[kt][8 * s2 + 0], st[kt][8 * s2 + 1]), w1 = pg8::cvt_pk_bf16(st[kt][8 * s2 + 2], st[kt][8 * s2 + 3]),
                                      w2 = pg8::cvt_pk_bf16(st[kt][8 * s2 + 4], st[kt][8 * s2 + 5]), w3 = pg8::cvt_pk_bf16(st[kt][8 * s2 + 6], st[kt][8 * s2 + 7]);
                             u32x4 ww = {w0, w1, w2, w3}; pb = __builtin_bit_cast(bf16x8, ww); }
#pragma unroll
                for (int dt = 0; dt < 2; ++dt) {
                    const s16x4 lo = vtr(lds + vrd + dt * 24576 + (kt * 32 + s2 * 16) * 64), hi = vtr(lds + vrd + dt * 24576 + (kt * 32 + s2 * 16 + 8) * 64);
                    bf16x8 av; av[0] = lo[0]; av[1] = lo[1]; av[2] = lo[2]; av[3] = lo[3]; av[4] = hi[0]; av[5] = hi[1]; av[6] = hi[2]; av[7] = hi[3];
                    if (dt == 0) o0 = __builtin_amdgcn_mfma_f32_32x32x16_bf16(av, pb, o0, 0, 0, 0); else o1 = __builtin_amdgcn_mfma_f32_32x32x16_bf16(av, pb, o1, 0, 0, 0);
                }
            }
        const float inv = 1.0f / sum; const size_t tok = t.rowbase + (size_t)(l0 + i32) * t.d + t.r;
        bf16_t* op = opart + ((size_t)t.pat * MT + tok) * AW + t.h * 64 + 16 * hh;
#pragma unroll
        for (int hv = 0; hv < 2; ++hv) {
            u32x4 w; w.x = pg8::cvt_pk_bf16(o0[8 * hv] * inv, o0[8 * hv + 1] * inv); w.y = pg8::cvt_pk_bf16(o0[8 * hv + 2] * inv, o0[8 * hv + 3] * inv);
            w.z = pg8::cvt_pk_bf16(o0[8 * hv + 4] * inv, o0[8 * hv + 5] * inv); w.w = pg8::cvt_pk_bf16(o0[8 * hv + 6] * inv, o0[8 * hv + 7] * inv); *(u32x4*)(op + 8 * hv) = w;
            u32x4 w2; w2.x = pg8::cvt_pk_bf16(o1[8 * hv] * inv, o1[8 * hv + 1] * inv); w2.y = pg8::cvt_pk_bf16(o1[8 * hv + 2] * inv, o1[8 * hv + 3] * inv);
            w2.z = pg8::cvt_pk_bf16(o1[8 * hv + 4] * inv, o1[8 * hv + 5] * inv); w2.w = pg8::cvt_pk_bf16(o1[8 * hv + 6] * inv, o1[8 * hv + 7] * inv); *(u32x4*)(op + 32 + 8 * hv) = w2;
        }
        if (hh == 0) *(f32x2*)(ml + (((size_t)t.pat * MT + tok) * 16 + t.h) * 2) = (f32x2){mx * 0.125f, sum};
        __syncthreads();
    }
#undef AT_ISSUE
}

__device__ __forceinline__ void combine_row(const bf16_t* opart, const float* ml, const bf16_t* yb, const float* ga, const float* gb, bf16_t* Y, size_t row, int lane) {
    const int head = lane >> 2;
    float m[3], l[3];
#pragma unroll
    for (int p = 0; p < 3; ++p) { const f32x2 v = *(const f32x2*)(ml + (((size_t)p * MT + row) * 16 + head) * 2); m[p] = v[0]; l[p] = v[1]; }
    const float mg = fmaxf(m[0], fmaxf(m[1], m[2]));
    float w[3], den = 0.f;
#pragma unroll
    for (int p = 0; p < 3; ++p) { w[p] = __expf(m[p] - mg) * l[p]; den += w[p]; }
    const float iden = 1.0f / den;
    float ya[16];
#pragma unroll
    for (int e = 0; e < 16; ++e) ya[e] = 0.f;
#pragma unroll
    for (int p = 0; p < 3; ++p) { const u32x4* src = (const u32x4*)(opart + ((size_t)p * MT + row) * AW + lane * 16); const float wp = w[p] * iden;
#pragma unroll
        for (int hv = 0; hv < 2; ++hv) { const u32x4 x = src[hv];
            ya[8 * hv + 0] += wp * bflo(x.x); ya[8 * hv + 1] += wp * bfhi(x.x); ya[8 * hv + 2] += wp * bflo(x.y); ya[8 * hv + 3] += wp * bfhi(x.y);
            ya[8 * hv + 4] += wp * bflo(x.z); ya[8 * hv + 5] += wp * bfhi(x.z); ya[8 * hv + 6] += wp * bflo(x.w); ya[8 * hv + 7] += wp * bfhi(x.w); } }
    float s = 0.f;
#pragma unroll
    for (int e = 0; e < 16; ++e) s += ya[e] * ya[e];
    float rstd = rsqrtf(wave_sum(s) * (1.f / AW) + EPS);
    {   u32x4 o[2];
#pragma unroll
        for (int hv = 0; hv < 2; ++hv) { const f32x4 g0 = *(const f32x4*)(ga + lane * 16 + 8 * hv), g1 = *(const f32x4*)(ga + lane * 16 + 8 * hv + 4);
            o[hv].x = pk2(ya[8 * hv] * rstd * g0[0], ya[8 * hv + 1] * rstd * g0[1]); o[hv].y = pk2(ya[8 * hv + 2] * rstd * g0[2], ya[8 * hv + 3] * rstd * g0[3]);
            o[hv].z = pk2(ya[8 * hv + 4] * rstd * g1[0], ya[8 * hv + 5] * rstd * g1[1]); o[hv].w = pk2(ya[8 * hv + 6] * rstd * g1[2], ya[8 * hv + 7] * rstd * g1[3]); }
        u32x4* dst = (u32x4*)(Y + row * DM + lane * 16); dst[0] = o[0]; dst[1] = o[1]; }
    float yv[16];
    { const u32x4* src = (const u32x4*)(yb + row * SW + lane * 16);
#pragma unroll
        for (int hv = 0; hv < 2; ++hv) { const u32x4 x = src[hv];
            yv[8 * hv + 0] = bflo(x.x); yv[8 * hv + 1] = bfhi(x.x); yv[8 * hv + 2] = bflo(x.y); yv[8 * hv + 3] = bfhi(x.y);
            yv[8 * hv + 4] = bflo(x.z); yv[8 * hv + 5] = bfhi(x.z); yv[8 * hv + 6] = bflo(x.w); yv[8 * hv + 7] = bfhi(x.w); } }
    s = 0.f;
#pragma unroll
    for (int e = 0; e < 16; ++e) s += yv[e] * yv[e];
    rstd = rsqrtf(wave_sum(s) * (1.f / SW) + EPS);
    {   u32x4 o[2];
#pragma unroll
        for (int hv = 0; hv < 2; ++hv) { const f32x4 g0 = *(const f32x4*)(gb + lane * 16 + 8 * hv), g1 = *(const f32x4*)(gb + lane * 16 + 8 * hv + 4);
            o[hv].x = pk2(yv[8 * hv] * rstd * g0[0], yv[8 * hv + 1] * rstd * g0[1]); o[hv].y = pk2(yv[8 * hv + 2] * rstd * g0[2], yv[8 * hv + 3] * rstd * g0[3]);
            o[hv].z = pk2(yv[8 * hv + 4] * rstd * g1[0], yv[8 * hv + 5] * rstd * g1[1]); o[hv].w = pk2(yv[8 * hv + 6] * rstd * g1[2], yv[8 * hv + 7] * rstd * g1[3]); }
        u32x4* dst = (u32x4*)(Y + row * DM + AW + lane * 16); dst[0] = o[0]; dst[1] = o[1]; }
}

__global__ void __launch_bounds__(512, 2) fwd_mega(Args a) {
    extern __shared__ __attribute__((aligned(16))) unsigned char lds_raw[];
    LAS unsigned char* lds = (LAS unsigned char*)lds_raw;
    cg::grid_group grid = cg::this_grid();
    const int tid = threadIdx.x, lane = tid & 63, wave = __builtin_amdgcn_readfirstlane(tid >> 6);
    const int G = gridDim.x, bx = blockIdx.x;
    const int gw = bx * 8 + wave, NGW = G * 8;
    unsigned char* ws = a.ws;
    bf16_t* H4 = (bf16_t*)(ws + WS_BIG);
    bf16_t* U = (bf16_t*)(ws + WS_U);
    float* ss_mix = (float*)(ws + WS_SS), *ss_f2 = ss_mix + MT, *ss_ple = ss_f2 + MT;
    volatile LAS unsigned* bst = (volatile LAS unsigned*)(lds + LDS_BYTES - 64);
    if (tid < 2) bst[tid] = 0u;
    if (bx == 0) for (int i = tid; i < XCD_BAR_WORDS; i += 512) __hip_atomic_store((unsigned*)(ws + WS_BAR) + i, 0u, __ATOMIC_RELAXED, __HIP_MEMORY_SCOPE_AGENT);

    for (int i = bx * 512 + tid; i < 3 * MT; i += G * 512) ss_mix[i] = 0.f;
    if (bx < SG) ssm_precompute(a, bx, lds, tid);
    {
        LAS float* scr = (LAS float*)(lds + wave * 16640);
        transpose_set<0>(a, scr, gw, NGW, lane);
        if (G != 256) transpose_set<1>(a, scr, gw, NGW, lane);
        { const f32x4* src = (const f32x4*)a.in[I_P]; u32x2* dst = (u32x2*)(ws + WS_PBF); const size_t n4 = (size_t)MT * PLE / 4;
          for (size_t i = (size_t)bx * 512 + tid; i < n4; i += (size_t)G * 512) { const f32x4 v = src[i]; u32x2 w; w.x = pk2(v[0], v[1]); w.y = pk2(v[2], v[3]); dst[i] = w; } }
        for (int m = gw; m < MT; m += 2 * NGW) rms_row2_bf16(a.in[I_X] + (size_t)m * DM, a.in[I_X] + (size_t)(m + NGW) * DM, a.in[I_F1N], U + (size_t)m * DM, U + (size_t)(m + NGW) * DM, lane);
    }
    grid.sync();
    const XcdBarrier bar = xcd_barrier_post((unsigned*)(ws + WS_BAR), bst);
#define SEAM() xcd_barrier(bar)

    pg8::StaticOrder S;
    { pg8::Gemm g{U, (const bf16_t*)(ws + WS_GU1), DM, DM, DM}; S.init(MT / 256, NGU / 256, G, bx, 0);
      pg8::EpiSwiGLU<false> E{(bf16_t*)(ws + WS_HID), nullptr}; E.last_pm = -1; pg8::gemm_phase(lds, g, S, E); }
    if (G == 256 && bx >= 128) {
        transpose_set<1>(a, (LAS float*)(lds + wave * 16640), (bx - 128) * 8 + wave, 1024, lane); __syncthreads(); }
    SEAM();
    { pg8::Gemm g{(const bf16_t*)(ws + WS_HID), (const bf16_t*)(ws + WS_DN1), FF, FF, FF}; S.init(MT / 256, DM / 256, G, bx, 0, 4);
      pg8::EpiResid<true> E{a.in[I_X], U, ss_mix, 0.5f}; pg8::gemm_phase(lds, g, S, E); }
    SEAM();
    { pg8::Gemm g{U, (const bf16_t*)(ws + WS_WIN), DM, DM, DM}; S.init(MT / 256, NIN / 256, G, bx, 0);
      pg8::EpiWin E{(bf16_t*)(ws + WS_QKV), (bf16_t*)(ws + WS_ASSM), ss_mix}; pg8::gemm_phase(lds, g, S, E); }
    SEAM();
    { pg8::Gemm g{(const bf16_t*)(ws + WS_ASSM), (const bf16_t*)(ws + WS_EB), KT, 256, 256}; S.init(SG * ROWS_G / 256, 1, G, bx, ROWS_G / 256);
      pg8::EpiE E{(float*)(ws + WS_E)}; pg8::gemm_phase(lds, g, S, E); }
    __syncthreads();
    attn_phase((const bf16_t*)(ws + WS_QKV), (bf16_t*)(ws + WS_OP), (float*)(ws + WS_ML), lds, wave, lane, G);
    SEAM();
    if (wave == 0 && bx < SG * 4) {
        const int g = bx >> 2, b = bx & 3, p = lane;
        const float2 a16 = ((const float2*)(ws + WS_A16))[g * 64 + p];
        const float* Eb = (const float*)(ws + WS_E) + ((size_t)g * ROWS_G + b * NCH) * 128;
        bf16_t* As = (bf16_t*)(ws + WS_ASSM) + ((size_t)g * ROWS_G + b * NCH) * KT + 256;
        float hr = 0.f, hi = 0.f;
        for (int c0 = 0; c0 < NCH; c0 += 16) {
            float er[16], ei[16];
#pragma unroll
            for (int j = 0; j < 16; ++j) { er[j] = Eb[(size_t)(c0 + j) * 128 + p]; ei[j] = Eb[(size_t)(c0 + j) * 128 + 64 + p]; }
#pragma unroll
            for (int j = 0; j < 16; ++j) { As[(size_t)(c0 + j) * KT + p] = (bf16_t)f2bf(hr); As[(size_t)(c0 + j) * KT + 64 + p] = (bf16_t)f2bf(hi);
                const float nr = a16.x * hr - a16.y * hi + er[j], ni = a16.x * hi + a16.y * hr + ei[j]; hr = nr; hi = ni; }
        }
    }
    SEAM();
    { pg8::Gemm g{(const bf16_t*)(ws + WS_ASSM), (const bf16_t*)(ws + WS_TG), KT, KT, KT}; S.init(SG * ROWS_G / 256, 1, G, bx, ROWS_G / 256);
      pg8::EpiToep E{(bf16_t*)(ws + WS_E)}; pg8::gemm_phase(lds, g, S, E); }
    SEAM();
    { pg8::Gemm g{(const bf16_t*)(ws + WS_E), (const bf16_t*)(ws + WS_WGLU), SW, SW, SW}; S.init(MT / 256, SW / 256, G, bx, 0);
      pg8::EpiGLU E{(const bf16_t*)(ws + WS_E), a.in[I_BGLU], (bf16_t*)(ws + WS_ASSM)}; pg8::gemm_phase(lds, g, S, E); }
    SEAM();
    for (int m = gw; m < MT; m += NGW) combine_row((const bf16_t*)(ws + WS_OP), (const float*)(ws + WS_ML), (const bf16_t*)(ws + WS_ASSM), a.in[I_AON], a.in[I_SON], (bf16_t*)(ws + WS_Y), (size_t)m, lane);
    SEAM();
    { pg8::Gemm g{(const bf16_t*)(ws + WS_Y), (const bf16_t*)(ws + WS_WOUT), DM, DM, DM}; S.init(MT / 256, DM / 256, G, bx, 0, 4);
      pg8::EpiResid<false> E{nullptr, U, ss_f2, 1.0f}; pg8::gemm_phase(lds, g, S, E); }
    SEAM();
    { pg8::Gemm g{U, (const bf16_t*)(ws + WS_GU2), DM, DM, DM}; S.init(MT / 256, NGU / 256, G, bx, 0);
      pg8::EpiSwiGLU<true> E{(bf16_t*)(ws + WS_HID), ss_f2}; E.last_pm = -1; pg8::gemm_phase(lds, g, S, E); }
    {
      const bool tail_fill = (G == 256); pg8::Gemm g{(const bf16_t*)(ws + WS_PBF), (const bf16_t*)(ws + WS_WPLE), PLE, PLE, PLE};
      if (tail_fill) S.init(MT / 256, DM / 256, 128, bx - 128, 0); else S.init(MT / 256, DM / 256, G, bx, 0, 4);
      pg8::EpiBf16 E{(bf16_t*)(ws + WS_PP), DM}; if (!tail_fill || bx >= 128) pg8::gemm_phase(lds, g, S, E); }
    SEAM();
    { pg8::Gemm g{(const bf16_t*)(ws + WS_HID), (const bf16_t*)(ws + WS_DN2), FF, FF, FF}; S.init(MT / 256, DM / 256, G, bx, 0, 4);
      pg8::EpiResid<false> E{nullptr, U, ss_ple, 0.5f}; pg8::gemm_phase(lds, g, S, E); }
    SEAM();
    { pg8::Gemm g{U, (const bf16_t*)(ws + WS_WPG), DM, DM, DM}; S.init(MT / 256, DM / 256, G, bx, 0, 4);
      pg8::EpiPleGate E{H4, U, (const bf16_t*)(ws + WS_PP), ss_ple}; pg8::gemm_phase(lds, g, S, E); }
    SEAM();
    for (int m = gw; m < MT; m += 2 * NGW) rms_row2_out(H4 + (size_t)m * DM, H4 + (size_t)(m + NGW) * DM, a.out + (size_t)m * DM, a.out + (size_t)(m + NGW) * DM, a.in[I_FINN], lane);
}

extern "C" void kernel_launch(void* const* d_in, const int* in_sizes, int n_in, void* d_out, int out_size, void* d_ws, size_t ws_size, hipStream_t stream) {
    static int grid = 0;
    if (grid == 0) {
        if (n_in != 29 || out_size != MT * DM || ws_size < WS_END) { fprintf(stderr, "kernel_launch: unexpected problem (n_in %d out %d ws %zu need %zu)\n", n_in, out_size, ws_size, (size_t)WS_END); grid = -1; return; }
        int dev = 0, cus = 0, per_cu = 0;
        (void)hipGetDevice(&dev);
        (void)hipDeviceGetAttribute(&cus, hipDeviceAttributeMultiprocessorCount, dev);
        (void)hipFuncSetAttribute((const void*)fwd_mega, hipFuncAttributeMaxDynamicSharedMemorySize, LDS_BYTES);
        (void)hipOccupancyMaxActiveBlocksPerMultiprocessor(&per_cu, (const void*)fwd_mega, 512, LDS_BYTES);
        (void)hipGetLastError();
        grid = cus;
        fprintf(stderr, "kernel_launch: cus %d per_cu %d grid %d ws %zu need %zu\n", cus, per_cu, grid, ws_size, (size_t)WS_END);
    }
    if (grid < 0) return;
    Args a{};
    for (int i = 0; i < 29; ++i) a.in[i] = (const float*)d_in[i];
    a.out = (float*)d_out; a.ws = (unsigned char*)d_ws;
    void* args[] = {&a};
    hipError_t e = hipLaunchCooperativeKernel((const void*)fwd_mega, dim3(grid), dim3(512), args, LDS_BYTES, stream);
    if (e != hipSuccess) fprintf(stderr, "kernel_launch: cooperative launch failed: %s\n", hipGetErrorString(e));
}
```

```cpp
#include <hip/hip_runtime.h>
#include <hip/hip_cooperative_groups.h>
#include <cstdio>
#include <cstdint>
namespace cg = cooperative_groups;

#define LAS __attribute__((address_space(3)))
typedef unsigned short bf16_t;
typedef short bf16x8 __attribute__((ext_vector_type(8)));
typedef short s16x4 __attribute__((ext_vector_type(4)));
typedef float f32x4 __attribute__((ext_vector_type(4)));
typedef float f32x2 __attribute__((ext_vector_type(2)));
typedef float f32x16 __attribute__((ext_vector_type(16)));
typedef unsigned u32x4 __attribute__((ext_vector_type(4)));
typedef unsigned u32x2 __attribute__((ext_vector_type(2)));

constexpr int SEQ = 8192, DM = 2048, MT = 32768, FF = 5504, NGU = 2 * FF, NIN = 4096, AW = 1024, SW = 1024, PLE = 256;
constexpr int SG = 64, SP = 64, SC = 16, LC = 16, NCH = SEQ / LC, ROWS_G = 4 * NCH  , KT = 384;
constexpr float EPS = 1e-6f;

constexpr size_t MiB = 1u << 20;
constexpr size_t al(size_t x) { return (x + MiB - 1) / MiB * MiB; }
constexpr size_t WS_GU1 = 0;
constexpr size_t WS_DN1 = WS_GU1 + al((size_t)NGU * DM * 2);
constexpr size_t WS_GU2 = WS_DN1 + al((size_t)DM * FF * 2);
constexpr size_t WS_DN2 = WS_GU2 + al((size_t)NGU * DM * 2);
constexpr size_t WS_WIN = WS_DN2 + al((size_t)DM * FF * 2);
constexpr size_t WS_WOUT = WS_WIN + al((size_t)NIN * DM * 2);
constexpr size_t WS_WPG = WS_WOUT + al((size_t)DM * DM * 2);
constexpr size_t WS_WPLE = WS_WPG + al((size_t)DM * DM * 2);
constexpr size_t WS_WGLU = WS_WPLE + al((size_t)DM * PLE * 2);
constexpr size_t WS_TG = WS_WGLU + al((size_t)SW * SW * 2);
constexpr size_t WS_EB = WS_TG + al((size_t)SG * 256 * KT * 2);
constexpr size_t WS_PBF = WS_EB + al((size_t)SG * 256 * 256 * 2);
constexpr size_t WS_A16 = WS_PBF + al((size_t)MT * PLE * 2);
constexpr size_t WS_BAR = WS_A16 + 65536;
constexpr size_t WS_SS = WS_A16 + 131072;
constexpr size_t WS_U = WS_A16 + MiB;
constexpr size_t WS_BIG = WS_U + al((size_t)MT * DM * 2);
constexpr size_t WS_HID = WS_BIG;
constexpr size_t WS_QKV = WS_BIG;
constexpr size_t WS_ASSM = WS_QKV + al((size_t)MT * 3072 * 2);
constexpr size_t WS_E = WS_ASSM + al((size_t)SG * ROWS_G * KT * 2);
constexpr size_t WS_OP = WS_E + al((size_t)SG * ROWS_G * 128 * 4);
constexpr size_t WS_ML = WS_OP + al((size_t)3 * MT * AW * 2);
constexpr size_t WS_MIXEND = WS_ML + al((size_t)3 * MT * 16 * 2 * 4);
constexpr size_t WS_Y = WS_BIG;
constexpr size_t WS_PP = WS_BIG + 384 * MiB;
constexpr size_t WS_END = (WS_MIXEND > WS_HID + al((size_t)MT * FF * 2)) ? WS_MIXEND : WS_HID + al((size_t)MT * FF * 2);
static_assert(WS_END <= (size_t)1024 * MiB && WS_PP >= WS_HID + (size_t)MT * FF * 2 && WS_PP + (size_t)MT * DM * 2 <= WS_END && WS_SS + 3 * MT * 4 <= WS_U, "workspace map");

constexpr int LDS_BYTES = 147456;

__device__ __forceinline__ unsigned f2bf(float f) { unsigned u = __builtin_bit_cast(unsigned, f); return (u + 0x7fffu + ((u >> 16) & 1u)) >> 16; }
__device__ __forceinline__ unsigned pk2(float lo, float hi) { return f2bf(lo) | (f2bf(hi) << 16); }
__device__ __forceinline__ float bflo(unsigned w) { return __builtin_bit_cast(float, w << 16); }
__device__ __forceinline__ float bfhi(unsigned w) { return __builtin_bit_cast(float, w & 0xffff0000u); }
__device__ __forceinline__ float fsigmoid(float x) { return __builtin_amdgcn_rcpf(1.0f + __expf(-x)); }
__device__ __forceinline__ float gelu_tanh(float x) { const float u = 1.5957691216057308f * (x + 0.044715f * x * x * x); return x * fsigmoid(u); }
__device__ __forceinline__ float wave_sum(float v) {
#pragma unroll
    for (int o = 1; o < 64; o <<= 1) v += __shfl_xor(v, o);
    return v;
}

namespace pg8 {
constexpr int BM = 256, BK = 64, HALF = 128, HTB = HALF * BK * 2, STAGE_BYTES = 8 * HTB, NXCD = 8, WGM = 4;
__host__ __device__ __forceinline__ int lds_byte(int r, int c) { const int st = (r >> 4) * 2 + (c >> 5), rr = r & 15, cc = c & 31, ob = rr * 64 + cc * 2; return st * 1024 + (ob ^ (((ob >> 9) & 1) << 5)); }
__host__ __device__ __forceinline__ void stage_rc(int b, int& R, int& C) { const int st = b / 1024, sb = b % 1024, swz = sb ^ (((sb >> 9) & 1) << 5); R = (st >> 1) * 16 + swz / 64; C = (st & 1) * 32 + (swz % 64) / 2; }
__host__ __device__ __forceinline__ int perm32(int rho) { const int n = rho >> 4, i = rho & 15; return 8 * (i >> 2) + 4 * n + (i & 3); }

struct Unit { int pm, pn, pb; };
struct Gemm { const bf16_t* A; const bf16_t* Bt; int lda, ldb, K; };

struct StaticOrder {
    int nM, nN, nwg, G, c, bdiv, wgm;
    __device__ void init(int nM_, int nN_, int G_, int c_, int bdiv_, int wgm_ = WGM) { nM = nM_; nN = nN_; nwg = nM * nN; G = G_; c = c_; bdiv = bdiv_; wgm = wgm_; }
    __device__ bool next(int i, Unit& u) const {
        const long L = (long)i * G + c; if (L >= nwg) return false;
        int wgid = (int)L; { const int q = nwg / NXCD, r = nwg % NXCD, xcd = wgid % NXCD, off = wgid / NXCD; wgid = (xcd < r ? xcd * (q + 1) : r * (q + 1) + (xcd - r) * q) + off; }
        const int nig = wgm * nN, gid = wgid / nig, fm = gid * wgm, gsz = (nM - fm) < wgm ? (nM - fm) : wgm;
        u.pm = fm + ((wgid % nig) % gsz); u.pn = (wgid % nig) / gsz; u.pb = bdiv ? (u.pm / bdiv) : u.pn; return true;
    }
};

__device__ __forceinline__ unsigned cvt_pk_bf16(float lo, float hi) { unsigned r; asm volatile("v_cvt_pk_bf16_f32 %0, %1, %2" : "=v"(r) : "v"(lo), "v"(hi)); return r; }

template <class Epi>
__device__ __forceinline__ void gemm_phase(LAS unsigned char* lds, const Gemm g, const StaticOrder& S, const Epi& E) {
    int tid_ = threadIdx.x; asm volatile("" : "+v"(tid_));
    const int tid = tid_, wid = __builtin_amdgcn_readfirstlane(tid >> 6), lane = tid & 63, wr = wid >> 2, wc = wid & 3, fr = lane & 15, fq = lane >> 4;
    int K_ = g.K; asm volatile("" : "+s"(K_));
    const int K = K_, nt = K / BK;
    unsigned voffA[2], voffB[2];
#pragma unroll
    for (int i = 0; i < 2; ++i) { int R, C; stage_rc(tid * 16 + i * 8192, R, C); const int Rb = Epi::PERM ? ((R & ~31) + perm32(R & 31)) : R;
        voffA[i] = (unsigned)(R * g.lda + C) * 2u; voffB[i] = (unsigned)(Rb * g.ldb + C) * 2u; }
    const size_t kstep = (size_t)(BK * 2);
    const size_t hstepA = (size_t)HALF * g.lda * 2, hstepB = (size_t)HALF * g.ldb * 2;
    const size_t tstepA = 2 * hstepA, tstepB = 2 * hstepB;
    const unsigned ldsw = (unsigned)wid * 1024u;
    const int aoff = lds_byte(wr * 64 + fr, fq * 8), boff = lds_byte(wc * 32 + fr, fq * 8);
#define PG8_SA(b, h) (((b) * 2 + (h)) * HTB)
#define PG8_SB(b, h) ((4 + (b) * 2 + (h)) * HTB)
#define PG8_STAGE(bufoff, gbase, voff) do { _Pragma("unroll") for (int _i = 0; _i < 2; ++_i) \
        __builtin_amdgcn_global_load_lds((const unsigned*)((const char*)(gbase) + (voff)[_i]), (LAS unsigned*)(lds + (bufoff) + ldsw + _i * 8192), 16, 0, 0); } while (0)
#define PG8_LDA(dst, b, h) do { _Pragma("unroll") for (int m = 0; m < 4; ++m) _Pragma("unroll") for (int k = 0; k < 2; ++k) dst[m][k] = *(const LAS bf16x8*)(lds + PG8_SA(b, h) + aoff + m * 2048 + k * 1024); } while (0)
#define PG8_LDB(dst, b, h) do { _Pragma("unroll") for (int n = 0; n < 2; ++n) _Pragma("unroll") for (int k = 0; k < 2; ++k) dst[n][k] = *(const LAS bf16x8*)(lds + PG8_SB(b, h) + boff + n * 2048 + k * 1024); } while (0)
#define PG8_MMA(ai, bj, At, Bt) do { __builtin_amdgcn_s_setprio(1); _Pragma("unroll") for (int m = 0; m < 4; ++m) _Pragma("unroll") for (int n = 0; n < 2; ++n) _Pragma("unroll") for (int k = 0; k < 2; ++k) \
        acc[ai][bj][m][n] = __builtin_amdgcn_mfma_f32_16x16x32_bf16(Bt[n][k], At[m][k], acc[ai][bj][m][n], 0, 0, 0); __builtin_amdgcn_s_setprio(0); } while (0)
#define PG8_WAIT_V(n) asm volatile("s_waitcnt vmcnt(" #n ")" ::: "memory")
#define PG8_WAIT_L(n) asm volatile("s_waitcnt lgkmcnt(" #n ")" ::: "memory")
#define PG8_BAR __builtin_amdgcn_s_barrier()
#define PG8_SCHED __builtin_amdgcn_sched_barrier(0)
    Unit cur, nxt; int ui = 0;
    if (!S.next(0, cur)) return;
    f32x4 acc[2][2][4][2];
#pragma unroll
    for (int a = 0; a < 2; ++a)
#pragma unroll
        for (int b = 0; b < 2; ++b)
#pragma unroll
            for (int m = 0; m < 4; ++m)
#pragma unroll
                for (int n = 0; n < 2; ++n) acc[a][b][m][n] = (f32x4){0.f, 0.f, 0.f, 0.f};
    bf16x8 At[4][2], B0[2][2], B1[2][2];
    const char* cA = (const char*)g.A + (size_t)cur.pm * tstepA; const char* cB = (const char*)g.Bt + (size_t)cur.pb * tstepB;
    PG8_STAGE(PG8_SB(0, 0), cB, voffB); PG8_STAGE(PG8_SB(0, 1), cB + hstepB, voffB); PG8_STAGE(PG8_SA(0, 0), cA, voffA); PG8_STAGE(PG8_SA(0, 1), cA + hstepA, voffA);
    if (wr == 1) PG8_BAR;
    PG8_WAIT_V(2); PG8_BAR;
    PG8_STAGE(PG8_SB(1, 0), cB + kstep, voffB); PG8_STAGE(PG8_SA(1, 0), cA + kstep, voffA); PG8_STAGE(PG8_SB(1, 1), cB + hstepB + kstep, voffB);
    PG8_WAIT_V(6); PG8_BAR;
    for (;;) {
        const bool has_next = S.next(ui + 1, nxt);
        const char* nA = has_next ? (const char*)g.A + (size_t)nxt.pm * tstepA : cA; const char* nB = has_next ? (const char*)g.Bt + (size_t)nxt.pb * tstepB : cB;
        for (int t = 0; t < nt; t += 2) {
            const bool last = (t == nt - 2);
            const char* a1 = cA + (size_t)(t + 1) * kstep;
            const char* a2 = last ? nA : cA + (size_t)(t + 2) * kstep; const char* b2 = last ? nB : cB + (size_t)(t + 2) * kstep;
            const char* a3 = a2 + kstep; const char* b3 = b2 + kstep;
            PG8_LDB(B0, 0, 0); PG8_LDB(B1, 0, 1); PG8_SCHED; PG8_LDA(At, 0, 0); PG8_STAGE(PG8_SA(1, 1), a1 + hstepA, voffA);
            PG8_WAIT_V(8); PG8_WAIT_L(0); PG8_BAR; PG8_MMA(0, 0, At, B0); PG8_MMA(0, 1, At, B1); PG8_BAR; PG8_SCHED;
            PG8_LDA(At, 0, 1); PG8_STAGE(PG8_SB(0, 0), b2, voffB); PG8_STAGE(PG8_SB(0, 1), b2 + hstepB, voffB); PG8_STAGE(PG8_SA(0, 0), a2, voffA);
            PG8_WAIT_V(8); PG8_WAIT_L(0); PG8_BAR; PG8_MMA(1, 0, At, B0); PG8_MMA(1, 1, At, B1); PG8_BAR; PG8_SCHED;
            PG8_LDB(B0, 1, 0); PG8_LDB(B1, 1, 1); PG8_SCHED; PG8_LDA(At, 1, 0); PG8_STAGE(PG8_SA(0, 1), a2 + hstepA, voffA);
            PG8_WAIT_V(8); PG8_WAIT_L(0); PG8_BAR; PG8_MMA(0, 0, At, B0); PG8_MMA(0, 1, At, B1); PG8_BAR; PG8_SCHED;
            PG8_LDA(At, 1, 1); PG8_STAGE(PG8_SB(1, 0), b3, voffB); PG8_STAGE(PG8_SB(1, 1), b3 + hstepB, voffB); PG8_STAGE(PG8_SA(1, 0), a3, voffA);
            PG8_WAIT_V(8); PG8_WAIT_L(0); PG8_BAR; PG8_MMA(1, 0, At, B0); PG8_MMA(1, 1, At, B1); PG8_BAR; PG8_SCHED;
        }
        if (wr == 0) PG8_BAR;
        E(acc, cur, wr, wc, fr, fq);
        if (!has_next) break;
#pragma unroll
        for (int a = 0; a < 2; ++a)
#pragma unroll
            for (int b = 0; b < 2; ++b)
#pragma unroll
                for (int m = 0; m < 4; ++m)
#pragma unroll
                    for (int n = 0; n < 2; ++n) acc[a][b][m][n] = (f32x4){0.f, 0.f, 0.f, 0.f};
        cur = nxt; cA = nA; cB = nB; ++ui;
        if (wr == 1) PG8_BAR;
    }
    PG8_WAIT_V(0);
    PG8_BAR;
#undef PG8_SA
#undef PG8_SB
#undef PG8_STAGE
#undef PG8_LDA
#undef PG8_LDB
#undef PG8_MMA
#undef PG8_WAIT_V
#undef PG8_WAIT_L
#undef PG8_BAR
#undef PG8_SCHED
}

typedef f32x4 Acc[2][2][4][2];
struct EpiSwiGLU {
    static constexpr bool PERM = true;
    bf16_t* H; const float* ss;
    __device__ __forceinline__ void operator()(const Acc& acc, const Unit& u, int wr, int wc, int fr, int fq) const {
        float rsv[2][4];
#pragma unroll
        for (int ai = 0; ai < 2; ++ai)
#pragma unroll
            for (int m = 0; m < 4; ++m) rsv[ai][m] = ss ? ss[(size_t)u.pm * BM + ai * HALF + wr * 64 + m * 16 + fr] : 0.f;
#pragma unroll
        for (int ai = 0; ai < 2; ++ai)
#pragma unroll
            for (int m = 0; m < 4; ++m) rsv[ai][m] = ss ? rsqrtf(rsv[ai][m] * (1.f / DM) + EPS) : 1.f;
        const int j0 = u.pn * HALF + wc * 32 + 8 * fq;
#pragma unroll
        for (int ai = 0; ai < 2; ++ai)
#pragma unroll
            for (int m = 0; m < 4; ++m) { const size_t row = (size_t)u.pm * BM + ai * HALF + wr * 64 + m * 16 + fr; const float rs = rsv[ai][m]; float h[8];
#pragma unroll
                for (int n = 0; n < 2; ++n) { const f32x4 gt = acc[ai][0][m][n] * rs, up = acc[ai][1][m][n] * rs;
#pragma unroll
                    for (int e = 0; e < 4; ++e) h[4 * n + e] = gt[e] * fsigmoid(gt[e]) * up[e]; }
                u32x4 w; w.x = cvt_pk_bf16(h[0], h[1]); w.y = cvt_pk_bf16(h[2], h[3]); w.z = cvt_pk_bf16(h[4], h[5]); w.w = cvt_pk_bf16(h[6], h[7]);
                *(u32x4*)(H + row * FF + j0) = w; }
    }
};
template <bool XBASE> struct EpiResid {
    static constexpr bool PERM = true;
    const float* basef; bf16_t* H; float* ss; float scale;
    __device__ __forceinline__ void operator()(Acc& acc, const Unit& u, int wr, int wc, int fr, int fq) const {
        const size_t off0 = ((size_t)u.pm * BM + wr * 64 + fr) * DM + u.pn * BM + wc * 32 + 8 * fq;
        u32x4 pa[2][2], pb[2][2];
#define ER_LOAD(ai, mp) _Pragma("unroll") for (int mm = 0; mm < 2; ++mm) _Pragma("unroll") for (int bj = 0; bj < 2; ++bj) { const size_t o2 = off0 + (size_t)((ai) * HALF + (2 * (mp) + mm) * 16) * DM + bj * HALF; \
            if constexpr (XBASE) { pa[mm][bj] = *(const u32x4*)(basef + o2); pb[mm][bj] = *(const u32x4*)(basef + o2 + 4); } else { pa[mm][bj] = *(const u32x4*)(H + o2); } }
#define ER_SUM(ai, mp) _Pragma("unroll") for (int mm = 0; mm < 2; ++mm) _Pragma("unroll") for (int bj = 0; bj < 2; ++bj) { f32x4 b0, b1; const u32x4 A = pa[mm][bj]; \
            if constexpr (XBASE) { b0 = __builtin_bit_cast(f32x4, A); b1 = __builtin_bit_cast(f32x4, pb[mm][bj]); } \
            else { b0 = (f32x4){bflo(A.x), bfhi(A.x), bflo(A.y), bfhi(A.y)}; b1 = (f32x4){bflo(A.z), bfhi(A.z), bflo(A.w), bfhi(A.w)}; } \
            acc[ai][bj][2 * (mp) + mm][0] = b0 + acc[ai][bj][2 * (mp) + mm][0] * scale; acc[ai][bj][2 * (mp) + mm][1] = b1 + acc[ai][bj][2 * (mp) + mm][1] * scale; }
#define ER_STORE(ai, mp) _Pragma("unroll") for (int mm = 0; mm < 2; ++mm) { const int m = 2 * (mp) + mm; const size_t o1 = off0 + (size_t)((ai) * HALF + m * 16) * DM; float part = 0.f; \
            _Pragma("unroll") for (int bj = 0; bj < 2; ++bj) { const size_t o2 = o1 + bj * HALF; const f32x4 v = acc[ai][bj][m][0], v2 = acc[ai][bj][m][1]; \
                part += ((v[0] * v[0] + v[1] * v[1]) + (v[2] * v[2] + v[3] * v[3])) + ((v2[0] * v2[0] + v2[1] * v2[1]) + (v2[2] * v2[2] + v2[3] * v2[3])); \
                u32x4 w; w.x = cvt_pk_bf16(v[0], v[1]); w.y = cvt_pk_bf16(v[2], v[3]); w.z = cvt_pk_bf16(v2[0], v2[1]); w.w = cvt_pk_bf16(v2[2], v2[3]); *(u32x4*)(H + o2) = w; } \
            part += __shfl_xor(part, 16); part += __shfl_xor(part, 32); \
            if (fq == 0) (void)__hip_atomic_fetch_add(ss + (size_t)u.pm * BM + (ai) * HALF + wr * 64 + m * 16 + fr, part, __ATOMIC_RELAXED, __HIP_MEMORY_SCOPE_AGENT); }
        ER_LOAD(0, 0) ER_SUM(0, 0) asm volatile("" ::: "memory"); ER_LOAD(0, 1) asm volatile("" ::: "memory"); ER_STORE(0, 0) ER_SUM(0, 1) asm volatile("" ::: "memory");
        ER_LOAD(1, 0) asm volatile("" ::: "memory"); ER_STORE(0, 1) ER_SUM(1, 0) asm volatile("" ::: "memory"); ER_LOAD(1, 1) asm volatile("" ::: "memory"); ER_STORE(1, 0) ER_SUM(1, 1) ER_STORE(1, 1)
#undef ER_LOAD
#undef ER_SUM
#undef ER_STORE
    }
};
struct EpiPleGate {
    static constexpr bool PERM = true;
    bf16_t* O; const bf16_t* H; const bf16_t* P; const float* ss;
    __device__ __forceinline__ void operator()(Acc& acc, const Unit& u, int wr, int wc, int fr, int fq) const {
        const size_t row0 = (size_t)u.pm * BM + wr * 64 + fr; const size_t off0 = row0 * DM + u.pn * BM + wc * 32 + 8 * fq;
        float rsv[2][4];
#pragma unroll
        for (int ai = 0; ai < 2; ++ai)
#pragma unroll
            for (int m = 0; m < 4; ++m) rsv[ai][m] = ss[row0 + ai * HALF + m * 16];
#pragma unroll
        for (int ai = 0; ai < 2; ++ai)
#pragma unroll
            for (int m = 0; m < 4; ++m) rsv[ai][m] = rsqrtf(rsv[ai][m] * (1.f / DM) + EPS);
        u32x4 ph[2][2], pp[2][2];
#define PG_LOAD(ai, mp) _Pragma("unroll") for (int mm = 0; mm < 2; ++mm) _Pragma("unroll") for (int bj = 0; bj < 2; ++bj) { \
            const size_t o2 = off0 + (size_t)((ai) * HALF + (2 * (mp) + mm) * 16) * DM + bj * HALF; ph[mm][bj] = *(const u32x4*)(H + o2); pp[mm][bj] = *(const u32x4*)(P + o2); }
#define PG_SUM(ai, mp) _Pragma("unroll") for (int mm = 0; mm < 2; ++mm) _Pragma("unroll") for (int bj = 0; bj < 2; ++bj) { const float rs = rsv[ai][2 * (mp) + mm]; const u32x4 h = ph[mm][bj], pw = pp[mm][bj]; \
            { const f32x4 a = acc[ai][bj][2 * (mp) + mm][0] * rs; f32x4 v; v[0] = bflo(h.x) + fsigmoid(a[0]) * bflo(pw.x); v[1] = bfhi(h.x) + fsigmoid(a[1]) * bfhi(pw.x); \
              v[2] = bflo(h.y) + fsigmoid(a[2]) * bflo(pw.y); v[3] = bfhi(h.y) + fsigmoid(a[3]) * bfhi(pw.y); acc[ai][bj][2 * (mp) + mm][0] = v; } \
            { const f32x4 a = acc[ai][bj][2 * (mp) + mm][1] * rs; f32x4 v; v[0] = bflo(h.z) + fsigmoid(a[0]) * bflo(pw.z); v[1] = bfhi(h.z) + fsigmoid(a[1]) * bfhi(pw.z); \
              v[2] = bflo(h.w) + fsigmoid(a[2]) * bflo(pw.w); v[3] = bfhi(h.w) + fsigmoid(a[3]) * bfhi(pw.w); acc[ai][bj][2 * (mp) + mm][1] = v; } }
#define PG_STORE(ai, mp) _Pragma("unroll") for (int mm = 0; mm < 2; ++mm) _Pragma("unroll") for (int bj = 0; bj < 2; ++bj) { const f32x4 v = acc[ai][bj][2 * (mp) + mm][0], v2 = acc[ai][bj][2 * (mp) + mm][1]; \
            u32x4 w; w.x = cvt_pk_bf16(v[0], v[1]); w.y = cvt_pk_bf16(v[2], v[3]); w.z = cvt_pk_bf16(v2[0], v2[1]); w.w = cvt_pk_bf16(v2[2], v2[3]); \
            *(u32x4*)(O + off0 + (size_t)((ai) * HALF + (2 * (mp) + mm) * 16) * DM + bj * HALF) = w; }
        PG_LOAD(0, 0) PG_SUM(0, 0) asm volatile("" ::: "memory"); PG_LOAD(0, 1) asm volatile("" ::: "memory"); PG_STORE(0, 0) PG_SUM(0, 1) asm volatile("" ::: "memory");
        PG_LOAD(1, 0) asm volatile("" ::: "memory"); PG_STORE(0, 1) PG_SUM(1, 0) asm volatile("" ::: "memory"); PG_LOAD(1, 1) asm volatile("" ::: "memory"); PG_STORE(1, 0) PG_SUM(1, 1) PG_STORE(1, 1)
#undef PG_LOAD
#undef PG_SUM
#undef PG_STORE
    }
};
struct EpiBf16 {
    static constexpr bool PERM = true;
    bf16_t* O; int ldc;
    __device__ __forceinline__ void operator()(const Acc& acc, const Unit& u, int wr, int wc, int fr, int fq) const {
#pragma unroll
        for (int ai = 0; ai < 2; ++ai)
#pragma unroll
            for (int m = 0; m < 4; ++m) { bf16_t* rowp = O + ((size_t)u.pm * BM + ai * HALF + wr * 64 + m * 16 + fr) * ldc + u.pn * BM + wc * 32 + 8 * fq;
#pragma unroll
                for (int bj = 0; bj < 2; ++bj) { const f32x4 v0 = acc[ai][bj][m][0], v1 = acc[ai][bj][m][1];
                    u32x4 w; w.x = cvt_pk_bf16(v0[0], v0[1]); w.y = cvt_pk_bf16(v0[2], v0[3]); w.z = cvt_pk_bf16(v1[0], v1[1]); w.w = cvt_pk_bf16(v1[2], v1[3]);
                    *(u32x4*)(rowp + bj * HALF) = w; } }
    }
};
struct EpiWin {
    static constexpr bool PERM = true;
    bf16_t* QKV; bf16_t* AS; const float* ss;
    __device__ __forceinline__ void operator()(const Acc& acc, const Unit& u, int wr, int wc, int fr, int fq) const {
        float rsv[2][4];
#pragma unroll
        for (int ai = 0; ai < 2; ++ai)
#pragma unroll
            for (int m = 0; m < 4; ++m) rsv[ai][m] = ss[u.pm * BM + ai * HALF + wr * 64 + m * 16 + fr];
#pragma unroll
        for (int ai = 0; ai < 2; ++ai)
#pragma unroll
            for (int m = 0; m < 4; ++m) rsv[ai][m] = rsqrtf(rsv[ai][m] * (1.f / DM) + EPS);
#pragma unroll
        for (int ai = 0; ai < 2; ++ai)
#pragma unroll
            for (int m = 0; m < 4; ++m) { const int row = u.pm * BM + ai * HALF + wr * 64 + m * 16 + fr;
                const float rs = rsv[ai][m];
#pragma unroll
                for (int bj = 0; bj < 2; ++bj) { const f32x4 v0 = acc[ai][bj][m][0] * rs, v1 = acc[ai][bj][m][1] * rs;
                    u32x4 w; w.x = cvt_pk_bf16(v0[0], v0[1]); w.y = cvt_pk_bf16(v0[2], v0[3]); w.z = cvt_pk_bf16(v1[0], v1[1]); w.w = cvt_pk_bf16(v1[2], v1[3]);
                    const int col0 = u.pn * BM + bj * HALF + wc * 32 + 8 * fq;
                    if (u.pn < 12) { const int which = col0 >> 10, hcol = col0 & 1023; *(u32x4*)(QKV + ((size_t)((which * 4 + (row >> 13)) * 16 + (hcol >> 6)) * SEQ + (row & 8191)) * 64 + (hcol & 63)) = w; }
                    else { const int ch = col0 - 3072, g = ch >> 4, c = ch & 15, b = row >> 13, t = row & 8191, chunk = t >> 4, tt = t & 15;
                        *(u32x4*)(AS + ((size_t)g * ROWS_G + b * NCH + chunk) * KT + tt * 16 + c) = w; } } }
    }
};
struct EpiE {
    static constexpr bool PERM = false;
    float* E;
    __device__ __forceinline__ void operator()(const Acc& acc, const Unit& u, int wr, int wc, int fr, int fq) const {
#pragma unroll
        for (int ai = 0; ai < 2; ++ai)
#pragma unroll
            for (int m = 0; m < 4; ++m) { float* rowp = E + ((size_t)u.pm * BM + ai * HALF + wr * 64 + m * 16 + fr) * 128 + wc * 32 + 4 * fq;
#pragma unroll
                for (int n = 0; n < 2; ++n) *(f32x4*)(rowp + n * 16) = acc[ai][0][m][n]; }
    }
};
struct EpiToep {
    static constexpr bool PERM = true;
    bf16_t* Y;
    __device__ __forceinline__ void operator()(const Acc& acc, const Unit& u, int wr, int wc, int fr, int fq) const {
#pragma unroll
        for (int ai = 0; ai < 2; ++ai)
#pragma unroll
            for (int m = 0; m < 4; ++m) { const int row = u.pm * BM + ai * HALF + wr * 64 + m * 16 + fr; const int g = row >> 11, rb = row & 2047, b = rb >> 9, chunk = rb & 511;
#pragma unroll
                for (int bj = 0; bj < 2; ++bj) { const f32x4 v0 = acc[ai][bj][m][0], v1 = acc[ai][bj][m][1];
                    u32x4 w; w.x = cvt_pk_bf16(gelu_tanh(v0[0]), gelu_tanh(v0[1])); w.y = cvt_pk_bf16(gelu_tanh(v0[2]), gelu_tanh(v0[3]));
                    w.z = cvt_pk_bf16(gelu_tanh(v1[0]), gelu_tanh(v1[1])); w.w = cvt_pk_bf16(gelu_tanh(v1[2]), gelu_tanh(v1[3]));
                    const int col0 = bj * HALF + wc * 32 + 8 * fq, tt = col0 >> 4, co = col0 & 15;
                    *(u32x4*)(Y + ((size_t)b * SEQ + chunk * LC + tt) * SW + g * 16 + co) = w; } }
    }
};
struct EpiGLU {
    static constexpr bool PERM = true;
    const bf16_t* Y; const float* bias; bf16_t* O;
    __device__ __forceinline__ void operator()(const Acc& acc, const Unit& u, int wr, int wc, int fr, int fq) const {
        const size_t off0 = ((size_t)u.pm * BM + wr * 64 + fr) * SW + u.pn * BM + wc * 32 + 8 * fq;
        f32x4 bv[2][2]; u32x4 yv[2][4][2];
#pragma unroll
        for (int bj = 0; bj < 2; ++bj) { bv[bj][0] = *(const f32x4*)(bias + u.pn * BM + bj * HALF + wc * 32 + 8 * fq); bv[bj][1] = *(const f32x4*)(bias + u.pn * BM + bj * HALF + wc * 32 + 8 * fq + 4); }
#pragma unroll
        for (int ai = 0; ai < 2; ++ai)
#pragma unroll
            for (int m = 0; m < 4; ++m)
#pragma unroll
                for (int bj = 0; bj < 2; ++bj) yv[ai][m][bj] = *(const u32x4*)(Y + off0 + (size_t)(ai * HALF + m * 16) * SW + bj * HALF);
        asm volatile("" ::: "memory");
#pragma unroll
        for (int ai = 0; ai < 2; ++ai)
#pragma unroll
            for (int m = 0; m < 4; ++m)
#pragma unroll
                for (int bj = 0; bj < 2; ++bj) { const f32x4 v0 = acc[ai][bj][m][0] + bv[bj][0], v1 = acc[ai][bj][m][1] + bv[bj][1]; const u32x4 y = yv[ai][m][bj];
                    u32x4 w; w.x = cvt_pk_bf16(bflo(y.x) * fsigmoid(v0[0]), bfhi(y.x) * fsigmoid(v0[1])); w.y = cvt_pk_bf16(bflo(y.y) * fsigmoid(v0[2]), bfhi(y.y) * fsigmoid(v0[3]));
                    w.z = cvt_pk_bf16(bflo(y.z) * fsigmoid(v1[0]), bfhi(y.z) * fsigmoid(v1[1])); w.w = cvt_pk_bf16(bflo(y.w) * fsigmoid(v1[2]), bfhi(y.w) * fsigmoid(v1[3]));
                    *(u32x4*)(O + off0 + (size_t)(ai * HALF + m * 16) * SW + bj * HALF) = w; }
    }
};
}

#define XB_TMO      128
#define XB_XCNT(j)  (256  + 64 * (j))
#define XB_XSUB(j)  (1280 + 64 * (j))
#define XB_XGEN(j)  (2304 + 64 * (j))
#define XB_TOP      3328
#define XB_TOPGEN   3392
#define XCD_BAR_WORDS 3456
#define XB_SPIN_CAP (1u << 23)
__device__ __forceinline__ unsigned xb_ld(unsigned* p)              { return __hip_atomic_load(p, __ATOMIC_RELAXED, __HIP_MEMORY_SCOPE_AGENT); }
__device__ __forceinline__ unsigned xb_add(unsigned* p, unsigned v) { return __hip_atomic_fetch_add(p, v, __ATOMIC_RELAXED, __HIP_MEMORY_SCOPE_AGENT); }
__device__ __forceinline__ unsigned xb_xcc_id() { return (unsigned)__builtin_amdgcn_s_getreg((3 << 11) | 20) & 0xFu; }
#define XB_SPIN(cond, bar) do { unsigned _sp = 0; while (cond) { __builtin_amdgcn_s_sleep(1); \
    if ((++_sp & 255u) == 0u) { if (xb_ld(&(bar)[XB_TMO])) break; if (_sp > XB_SPIN_CAP) { atomicAdd(&(bar)[XB_TMO], 1u); break; } } } } while (0)
struct XcdBarrier { unsigned* bar; unsigned x; volatile LAS unsigned* st; };
__device__ __forceinline__ XcdBarrier xcd_barrier_post(unsigned* bar, volatile LAS unsigned* st) {
    XcdBarrier b; b.bar = bar; b.x = xb_xcc_id(); b.st = st;
    if (threadIdx.x == 0) (void)xb_add(&bar[XB_XCNT(b.x)], 1u);
    return b;
}
__device__ __forceinline__ void xcd_barrier_complete(unsigned* bar, unsigned x, unsigned& nloc, unsigned& nx) {
    const unsigned G = gridDim.x * gridDim.y * gridDim.z;
    unsigned sum, cnt, mine, sp = 0u;
    for (;;) {
        sum = 0u; cnt = 0u; mine = 0u;
#pragma unroll
        for (unsigned j = 0; j < 16; ++j) { const unsigned c = xb_ld(&bar[XB_XCNT(j)]); sum += c; cnt += (c > 0u) ? 1u : 0u; mine = (j == x) ? c : mine; }
        if (sum == G) break;
        __builtin_amdgcn_s_sleep(1);
        if ((++sp & 255u) == 0u) { if (xb_ld(&bar[XB_TMO])) break; if (sp > XB_SPIN_CAP) { atomicAdd(&bar[XB_TMO], 1u); break; } }
    }
    nloc = mine > 0u ? mine : 1u; nx = cnt > 0u ? cnt : 1u;
}
__device__ __forceinline__ void xcd_barrier(const XcdBarrier& b) {
    asm volatile("s_waitcnt vmcnt(0)" ::: "memory");
    __syncthreads();
    if (threadIdx.x == 0) {
        unsigned* bar = b.bar;
        __builtin_amdgcn_s_waitcnt(0);
        unsigned nloc = b.st[0], nx = b.st[1];
        if (nloc == 0u) { xcd_barrier_complete(bar, b.x, nloc, nx); b.st[0] = nloc; b.st[1] = nx; }
        const unsigned old = xb_add(&bar[XB_XSUB(b.x)], 1u);
        const unsigned gen = old / nloc;
        if (old + 1u == (gen + 1u) * nloc) {
            __builtin_amdgcn_fence(__ATOMIC_RELEASE, "agent");
            asm volatile("s_waitcnt vmcnt(0)" ::: "memory");
            const unsigned og = xb_add(&bar[XB_TOP], 1u);
            const unsigned tg = og / nx;
            if (og + 1u == (tg + 1u) * nx) xb_add(&bar[XB_TOPGEN], 1u);
            else XB_SPIN(xb_ld(&bar[XB_TOPGEN]) == tg, bar);
            __builtin_amdgcn_fence(__ATOMIC_ACQUIRE, "agent");
            xb_add(&bar[XB_XGEN(b.x)], 1u);
            asm volatile("s_waitcnt vmcnt(0)" ::: "memory");
        } else {
            XB_SPIN(xb_ld(&bar[XB_XGEN(b.x)]) == gen, bar);
            __builtin_amdgcn_fence(__ATOMIC_ACQUIRE, "agent");
            asm volatile("s_waitcnt vmcnt(0)" ::: "memory");
        }
    }
    __syncthreads();
}

struct Args { const float* in[29]; float* out; unsigned char* ws; };
enum { I_X = 0, I_P, I_F1N, I_F1G, I_F1U, I_F1D, I_MIXN, I_WIN, I_AON, I_LRE, I_LIM, I_LDT, I_BRE, I_BIM, I_CRE, I_CIM, I_SD, I_WGLU, I_BGLU, I_SON, I_WOUT,
       I_F2N, I_F2G, I_F2U, I_F2D, I_PLN, I_WPG, I_WPLE, I_FINN };

__device__ __forceinline__ void transpose_item(const float* W, const float* gain, int K, int N, bf16_t* WT, int mode, LAS float* scr, int item, int lane) {
    const int nblk = N / 64, kb = item / nblk, nb = item % nblk, k0 = 64 * kb, n0 = 64 * nb;
    const int kl = lane >> 4, n4 = lane & 15;
    f32x4 tv[16];
#pragma unroll
    for (int i = 0; i < 16; ++i) tv[i] = *(const f32x4*)(W + (size_t)(k0 + 4 * i + kl) * N + n0 + 4 * n4);
#pragma unroll
    for (int i = 0; i < 16; ++i) { const int kk = 4 * i + kl; f32x4 v = tv[i];
        if (gain) v = v * gain[k0 + kk];
        LAS float* d = scr + kk * 65 + 4 * n4; d[0] = v[0]; d[1] = v[1]; d[2] = v[2]; d[3] = v[3]; }
    asm volatile("s_waitcnt lgkmcnt(0)" ::: "memory");
    const int c = lane & 7;
#pragma unroll
    for (int j = 0; j < 8; ++j) { const int n = (lane >> 3) + 8 * j; const LAS float* s = scr + (8 * c) * 65 + n;
        u32x4 o; o.x = pk2(s[0 * 65], s[1 * 65]); o.y = pk2(s[2 * 65], s[3 * 65]); o.z = pk2(s[4 * 65], s[5 * 65]); o.w = pk2(s[6 * 65], s[7 * 65]);
        const int ns = n0 + n; const int dr = (mode == 0) ? ns : (((ns >> 7) << 8) + (ns & 127) + (mode == 2 ? 128 : 0));
        *(u32x4*)(WT + (size_t)dr * K + k0 + 8 * c) = o; }
    asm volatile("s_waitcnt lgkmcnt(0)" ::: "memory");
}

template <int SET>
__device__ __forceinline__ void transpose_set(const Args& a, LAS float* scr, int gw, int NGW, int lane) {
    unsigned char* ws = a.ws;
    constexpr int I_GU = (DM / 64) * (FF / 64), I_DN = (FF / 64) * (DM / 64), I_IN = (DM / 64) * (NIN / 64), I_SQ = (DM / 64) * (DM / 64), I_PL = (PLE / 64) * (DM / 64), I_GL = (SW / 64) * (SW / 64);
    if constexpr (SET == 0) {
        constexpr int NITEMS = 2 * I_GU + I_DN + I_IN + I_SQ + I_GL;
        for (int it = gw; it < NITEMS; it += NGW) {
            int r = it;
            if (r < I_GU) { transpose_item(a.in[I_F1G], nullptr, DM, FF, (bf16_t*)(ws + WS_GU1), 1, scr, r, lane); continue; } r -= I_GU;
            if (r < I_GU) { transpose_item(a.in[I_F1U], nullptr, DM, FF, (bf16_t*)(ws + WS_GU1), 2, scr, r, lane); continue; } r -= I_GU;
            if (r < I_DN) { transpose_item(a.in[I_F1D], nullptr, FF, DM, (bf16_t*)(ws + WS_DN1), 0, scr, r, lane); continue; } r -= I_DN;
            if (r < I_IN) { transpose_item(a.in[I_WIN], a.in[I_MIXN], DM, NIN, (bf16_t*)(ws + WS_WIN), 0, scr, r, lane); continue; } r -= I_IN;
            if (r < I_SQ) { transpose_item(a.in[I_WOUT], nullptr, DM, DM, (bf16_t*)(ws + WS_WOUT), 0, scr, r, lane); continue; } r -= I_SQ;
            transpose_item(a.in[I_WGLU], nullptr, SW, SW, (bf16_t*)(ws + WS_WGLU), 0, scr, r, lane);
        }
    } else {
        constexpr int NITEMS = 2 * I_GU + I_DN + I_SQ + I_PL;
        for (int it = gw; it < NITEMS; it += NGW) {
            int r = it;
            if (r < I_GU) { transpose_item(a.in[I_F2G], a.in[I_F2N], DM, FF, (bf16_t*)(ws + WS_GU2), 1, scr, r, lane); continue; } r -= I_GU;
            if (r < I_GU) { transpose_item(a.in[I_F2U], a.in[I_F2N], DM, FF, (bf16_t*)(ws + WS_GU2), 2, scr, r, lane); continue; } r -= I_GU;
            if (r < I_DN) { transpose_item(a.in[I_F2D], nullptr, FF, DM, (bf16_t*)(ws + WS_DN2), 0, scr, r, lane); continue; } r -= I_DN;
            if (r < I_SQ) { transpose_item(a.in[I_WPG], a.in[I_PLN], DM, DM, (bf16_t*)(ws + WS_WPG), 0, scr, r, lane); continue; } r -= I_SQ;
            transpose_item(a.in[I_WPLE], nullptr, PLE, DM, (bf16_t*)(ws + WS_WPLE), 0, scr, r, lane);
        }
    }
}

__device__ __forceinline__ void rms_row_bf16(const float* xrow, const float* gain, bf16_t* orow, int lane) {
    const f32x4* xr = (const f32x4*)xrow + lane; const f32x4* gr = (const f32x4*)gain + lane;
    f32x4 v[8]; float s = 0.f;
#pragma unroll
    for (int j = 0; j < 8; ++j) { v[j] = xr[64 * j]; s += (v[j][0] * v[j][0] + v[j][1] * v[j][1]) + (v[j][2] * v[j][2] + v[j][3] * v[j][3]); }
    const float rstd = rsqrtf(wave_sum(s) * (1.f / DM) + EPS);
    u32x2* o8 = (u32x2*)orow + lane;
#pragma unroll
    for (int j = 0; j < 8; ++j) { const f32x4 g = gr[64 * j]; u32x2 w; w.x = pk2(v[j][0] * rstd * g[0], v[j][1] * rstd * g[1]); w.y = pk2(v[j][2] * rstd * g[2], v[j][3] * rstd * g[3]); o8[64 * j] = w; }
}
__device__ __forceinline__ void rms_row_f32(float* xrow, const float* gain, int lane) {
    f32x4* xr = (f32x4*)xrow + lane; const f32x4* gr = (const f32x4*)gain + lane;
    f32x4 v[8]; float s = 0.f;
#pragma unroll
    for (int j = 0; j < 8; ++j) { v[j] = xr[64 * j]; s += (v[j][0] * v[j][0] + v[j][1] * v[j][1]) + (v[j][2] * v[j][2] + v[j][3] * v[j][3]); }
    const float rstd = rsqrtf(wave_sum(s) * (1.f / DM) + EPS);
#pragma unroll
    for (int j = 0; j < 8; ++j) { const f32x4 g = gr[64 * j]; xr[64 * j] = v[j] * rstd * g; }
}

__device__ __forceinline__ void rms_row2_bf16(const float* x0, const float* x1, const float* gain, bf16_t* o0, bf16_t* o1, int lane) {
    const f32x4* xa = (const f32x4*)x0 + lane; const f32x4* xb = (const f32x4*)x1 + lane; const f32x4* gr = (const f32x4*)gain + lane;
    f32x4 va[8], vb[8]; float sa = 0.f, sb = 0.f;
#pragma unroll
    for (int j = 0; j < 8; ++j) va[j] = xa[64 * j];
#pragma unroll
    for (int j = 0; j < 8; ++j) vb[j] = xb[64 * j];
#pragma unroll
    for (int j = 0; j < 8; ++j) { sa += (va[j][0] * va[j][0] + va[j][1] * va[j][1]) + (va[j][2] * va[j][2] + va[j][3] * va[j][3]); sb += (vb[j][0] * vb[j][0] + vb[j][1] * vb[j][1]) + (vb[j][2] * vb[j][2] + vb[j][3] * vb[j][3]); }
    const float ra = rsqrtf(wave_sum(sa) * (1.f / DM) + EPS), rb = rsqrtf(wave_sum(sb) * (1.f / DM) + EPS);
    u32x2* pa = (u32x2*)o0 + lane; u32x2* pb = (u32x2*)o1 + lane;
#pragma unroll
    for (int j = 0; j < 8; ++j) { const f32x4 g = gr[64 * j]; u32x2 w; w.x = pk2(va[j][0] * ra * g[0], va[j][1] * ra * g[1]); w.y = pk2(va[j][2] * ra * g[2], va[j][3] * ra * g[3]); pa[64 * j] = w;
        u32x2 w2; w2.x = pk2(vb[j][0] * rb * g[0], vb[j][1] * rb * g[1]); w2.y = pk2(vb[j][2] * rb * g[2], vb[j][3] * rb * g[3]); pb[64 * j] = w2; }
}
__device__ __forceinline__ void rms_row2_out(const bf16_t* x0, const bf16_t* x1, float* y0, float* y1, const float* gain, int lane) {
    const u32x4* xa = (const u32x4*)x0 + lane; const u32x4* xb = (const u32x4*)x1 + lane;
    u32x4 ra4[4], rb4[4];
#pragma unroll
    for (int j = 0; j < 4; ++j) ra4[j] = xa[64 * j];
#pragma unroll
    for (int j = 0; j < 4; ++j) rb4[j] = xb[64 * j];
    float va[4][8], vb[4][8]; float sa = 0.f, sb = 0.f;
#pragma unroll
    for (int j = 0; j < 4; ++j) { const u32x4 A = ra4[j], B = rb4[j];
        va[j][0] = bflo(A.x); va[j][1] = bfhi(A.x); va[j][2] = bflo(A.y); va[j][3] = bfhi(A.y); va[j][4] = bflo(A.z); va[j][5] = bfhi(A.z); va[j][6] = bflo(A.w); va[j][7] = bfhi(A.w);
        vb[j][0] = bflo(B.x); vb[j][1] = bfhi(B.x); vb[j][2] = bflo(B.y); vb[j][3] = bfhi(B.y); vb[j][4] = bflo(B.z); vb[j][5] = bfhi(B.z); vb[j][6] = bflo(B.w); vb[j][7] = bfhi(B.w);
#pragma unroll
        for (int e = 0; e < 8; ++e) { sa += va[j][e] * va[j][e]; sb += vb[j][e] * vb[j][e]; } }
    const float ra = rsqrtf(wave_sum(sa) * (1.f / DM) + EPS), rb = rsqrtf(wave_sum(sb) * (1.f / DM) + EPS);
    const f32x4* gr = (const f32x4*)gain + 2 * lane; f32x4* ya = (f32x4*)y0 + 2 * lane; f32x4* yb_ = (f32x4*)y1 + 2 * lane;
#pragma unroll
    for (int j = 0; j < 4; ++j) { const f32x4 g0 = gr[128 * j], g1 = gr[128 * j + 1];
        ya[128 * j] = (f32x4){va[j][0] * ra * g0[0], va[j][1] * ra * g0[1], va[j][2] * ra * g0[2], va[j][3] * ra * g0[3]};
        ya[128 * j + 1] = (f32x4){va[j][4] * ra * g1[0], va[j][5] * ra * g1[1], va[j][6] * ra * g1[2], va[j][7] * ra * g1[3]};
        yb_[128 * j] = (f32x4){vb[j][0] * rb * g0[0], vb[j][1] * rb * g0[1], vb[j][2] * rb * g0[2], vb[j][3] * rb * g0[3]};
        yb_[128 * j + 1] = (f32x4){vb[j][4] * rb * g1[0], vb[j][5] * rb * g1[1], vb[j][6] * rb * g1[2], vb[j][7] * rb * g1[3]}; }
}

__device__ __forceinline__ void ssm_precompute(const Args& a, int g, LAS unsigned char* lds, int tid) {
    LAS float* pwr = (LAS float*)lds;
    LAS float* pwi = pwr + 17 * 64;
    LAS float* Bbr = pwi + 17 * 64;
    LAS float* Bbi = Bbr + 1024;
    LAS float* Cr = Bbi + 1024;
    LAS float* Ci = Cr + 1024;
    LAS float* Kt = Ci + 1024;
    LAS float* cf = Kt + 4096;
    const float dt = __expf(a.in[I_LDT][g]);
    if (tid < 64) {
        const int p = tid; const float lr = a.in[I_LRE][g * 64 + p], li = a.in[I_LIM][g * 64 + p];
        const float th = li * dt;
        const float rev = th * 0.15915494309189535f;
#pragma unroll 1
        for (int tau = 0; tau <= 16; ++tau) {
            const float mg = __expf(lr * dt * (float)tau);
            float rv = rev * (float)tau; rv = rv - rintf(rv);
            const float ang = rv * 6.283185307179586f;
            pwr[tau * 64 + p] = mg * __cosf(ang); pwi[tau * 64 + p] = mg * __sinf(ang);
        }
        const float ar = pwr[64 + p], ai = pwi[64 + p];
        const float nr = ar - 1.0f, ni = ai, den = lr * lr + li * li;
        cf[2 * p] = (nr * lr + ni * li) / den; cf[2 * p + 1] = (ni * lr - nr * li) / den;
        float2* a16 = (float2*)(a.ws + WS_A16);
        a16[g * 64 + p] = make_float2(pwr[16 * 64 + p], pwi[16 * 64 + p]);
    }
    __syncthreads();
    for (int e = tid; e < 1024; e += 512) { const int p = e >> 4; const float br = a.in[I_BRE][(size_t)g * 1024 + e], bi = a.in[I_BIM][(size_t)g * 1024 + e];
        const float cr = cf[2 * p], ci = cf[2 * p + 1]; Bbr[e] = cr * br - ci * bi; Bbi[e] = cr * bi + ci * br;
        Cr[e] = a.in[I_CRE][(size_t)g * 1024 + e]; Ci[e] = a.in[I_CIM][(size_t)g * 1024 + e]; }
    __syncthreads();
    for (int e = tid; e < 4096; e += 512) { const int tau = e >> 8, co = (e >> 4) & 15, ci = e & 15; float s = 0.f;
        for (int p = 0; p < 64; ++p) { const float mr = Cr[co * 64 + p] * pwr[tau * 64 + p] - Ci[co * 64 + p] * pwi[tau * 64 + p], mi = Cr[co * 64 + p] * pwi[tau * 64 + p] + Ci[co * 64 + p] * pwr[tau * 64 + p];
            s += mr * Bbr[p * 16 + ci] - mi * Bbi[p * 16 + ci]; }
        Kt[e] = s; }
    __syncthreads();
    bf16_t* TG = (bf16_t*)(a.ws + WS_TG) + (size_t)g * 256 * KT;
    for (int e = tid; e < 256 * KT; e += 512) { const int n = e / KT, k = e % KT, t = n >> 4, co = n & 15; float v;
        if (k < 256) { const int s = k >> 4, ci = k & 15; v = (t >= s) ? Kt[(t - s) * 256 + co * 16 + ci] : 0.f; if (t == s && co == ci) v += a.in[I_SD][g * 16 + co]; }
        else { const int q = k - 256, p = q & 63; const float mr = Cr[co * 64 + p] * pwr[(t + 1) * 64 + p] - Ci[co * 64 + p] * pwi[(t + 1) * 64 + p], mi = Cr[co * 64 + p] * pwi[(t + 1) * 64 + p] + Ci[co * 64 + p] * pwr[(t + 1) * 64 + p];
            v = (q < 64) ? mr : -mi; }
        TG[e] = (bf16_t)f2bf(v); }
    bf16_t* EB = (bf16_t*)(a.ws + WS_EB) + (size_t)g * 256 * 256;
    for (int e = tid; e < 256 * 256; e += 512) { const int n = e >> 8, k = e & 255, s = k >> 4, ci = k & 15; float v = 0.f;
        if (n < 128) { const int p = n & 63; const float wr_ = pwr[(15 - s) * 64 + p], wi_ = pwi[(15 - s) * 64 + p];
            v = (n < 64) ? (wr_ * Bbr[p * 16 + ci] - wi_ * Bbi[p * 16 + ci]) : (wr_ * Bbi[p * 16 + ci] + wi_ * Bbr[p * 16 + ci]); }
        EB[e] = (bf16_t)f2bf(v); }
    __syncthreads();
}

typedef short v4i16_t __attribute__((ext_vector_type(4)));
__device__ __forceinline__ s16x4 vtr(LAS const unsigned char* p) { return __builtin_bit_cast(s16x4, __builtin_amdgcn_ds_read_tr16_b64_v4i16((LAS v4i16_t*)p)); }
constexpr int AT_KP = 144;
constexpr int AT_VOFF = 384 * AT_KP;
constexpr int AT_NWU = 6144;
struct AttnUnitW { int d, r, h, L0; size_t rowbase; int pat; };
__device__ __forceinline__ AttnUnitW attn_decode(int wgu) {
    AttnUnitW t; t.pat = wgu >> 11; int rem = wgu & 2047; const int dsh = t.pat * 2; t.d = 1 << dsh;
    const int cg = rem & ((32 >> dsh) - 1); rem >>= (5 - dsh); t.r = rem & (t.d - 1); rem >>= dsh; t.h = rem & 15; t.rowbase = (size_t)(rem >> 4) * SEQ; t.L0 = cg * 256; return t;
}
__device__ __forceinline__ void attn_phase(const bf16_t* qkv, bf16_t* opart, float* ml, LAS unsigned char* lds, int wave, int lane, int G) {
    const int tid = threadIdx.x;
    const int i32 = lane & 31, hh = lane >> 5, g4 = lane >> 4, q4 = (lane & 15) >> 2, p4 = lane & 3;
    const int bx = blockIdx.x, vcu = (G % 8 == 0) ? (bx % 8) * (G / 8) + bx / 8 : bx;
    const int per = (AT_NWU + G - 1) / G;
    const int u0 = vcu * per, u1 = (u0 + per < AT_NWU) ? u0 + per : AT_NWU;
    if (u0 >= u1) return;
    const int skey = tid >> 3, sc = tid & 7;
    const unsigned kwoff = (unsigned)(skey * AT_KP + sc * 16), vwoff = (unsigned)(AT_VOFF + (sc >> 2) * 24576 + skey * 64 + (sc & 3) * 16);
    const unsigned krd = (unsigned)((32 * wave + i32) * AT_KP + hh * 16);
    const unsigned vrd = (unsigned)(AT_VOFF + (32 * wave + 4 * hh + q4) * 64 + (16 * (p4 & 1) + 8 * (g4 & 1) + 4 * (p4 >> 1)) * 2);
    u32x4 kreg[6], vreg[6]; bf16x8 qn[4];
    AttnUnitW cu = attn_decode(u0);
#define AT_ISSUE(t) do { const bf16_t* hb = qkv + ((t).rowbase * 16 + (size_t)(t).h * SEQ) * 64;     \
        _Pragma("unroll") for (int i = 0; i < 6; ++i) { int lk = (t).L0 - 128 + skey + 64 * i; lk = lk < 0 ? 0 : lk; \
            const bf16_t* gp = hb + ((size_t)lk * (t).d + (t).r) * 64 + sc * 8; kreg[i] = *(const u32x4*)(gp + (size_t)MT * AW); vreg[i] = *(const u32x4*)(gp + 2 * (size_t)MT * AW); } \
        const bf16_t* qp = hb + ((size_t)((t).L0 + 32 * wave + i32) * (t).d + (t).r) * 64 + hh * 8; \
        _Pragma("unroll") for (int ks = 0; ks < 4; ++ks) qn[ks] = *(const bf16x8*)(qp + ks * 16); } while (0)
    AT_ISSUE(cu);
    for (int u = u0; u < u1; ++u) {
#pragma unroll
        for (int i = 0; i < 6; ++i) { *(LAS u32x4*)(lds + kwoff + i * 64 * AT_KP) = kreg[i]; *(LAS u32x4*)(lds + vwoff + i * 64 * 64) = vreg[i]; }
        bf16x8 q[4];
#pragma unroll
        for (int ks = 0; ks < 4; ++ks) q[ks] = qn[ks];
        const AttnUnitW t = cu;
        __syncthreads();
        if (u + 1 < u1) { cu = attn_decode(u + 1); AT_ISSUE(cu); }
        const int l0 = t.L0 + 32 * wave;
        f32x16 st[5];
#pragma unroll
        for (int kt = 0; kt < 5; ++kt) {
            bf16x8 kf[4];
#pragma unroll
            for (int ks = 0; ks < 4; ++ks) kf[ks] = *(const LAS bf16x8*)(lds + krd + kt * 32 * AT_KP + ks * 32);
            f32x16 acc;
#pragma unroll
            for (int v = 0; v < 16; ++v) acc[v] = 0.f;
#pragma unroll
            for (int ks = 0; ks < 4; ++ks) acc = __builtin_amdgcn_mfma_f32_32x32x16_bf16(kf[ks], q[ks], acc, 0, 0, 0);
            st[kt] = acc;
        }
#pragma unroll
        for (int v = 0; v < 16; ++v) { const int j = (v & 3) + 8 * (v >> 2) + 4 * hh; if (j < i32) st[0][v] = -1e30f; if (j > i32) st[4][v] = -1e30f; }
        if (l0 < 128) {
#pragma unroll
            for (int kt = 0; kt < 4; ++kt)
#pragma unroll
                for (int v = 0; v < 16; ++v) { const int j = (v & 3) + 8 * (v >> 2) + 4 * hh; if (l0 - 128 + 32 * kt + j < 0) st[kt][v] = -1e30f; }
        }
        float mx = -1e30f;
#pragma unroll
        for (int kt = 0; kt < 5; ++kt)
#pragma unroll
            for (int v = 0; v < 16; v += 2) mx = fmaxf(mx, fmaxf(st[kt][v], st[kt][v + 1]));
        mx = fmaxf(mx, __shfl_xor(mx, 32));
        const float C = 0.125f * 1.4426950408889634f, mC = mx * C;
        float sum = 0.f;
#pragma unroll
        for (int kt = 0; kt < 5; ++kt)
#pragma unroll
            for (int v = 0; v < 16; ++v) { const float p = __builtin_amdgcn_exp2f(st[kt][v] * C - mC); st[kt][v] = p; sum += p; }
        sum += __shfl_xor(sum, 32);
        f32x16 o0, o1;
#pragma unroll
        for (int v = 0; v < 16; ++v) { o0[v] = 0.f; o1[v] = 0.f; }
#pragma unroll
        for (int kt = 0; kt < 5; ++kt)
#pragma unroll
            for (int s2 = 0; s2 < 2; ++s2) {
                bf16x8 pb; { unsigned w0 = pg8::cvt_pk_bf16(st[kt][8 * s2 + 0], st[kt][8 * s2 + 1]), w1 = pg8::cvt_pk_bf16(st[kt][8 * s2 + 2], st[kt][8 * s2 + 3]),
                                      w2 = pg8::cvt_pk_bf16(st[kt][8 * s2 + 4], st[kt][8 * s2 + 5]), w3 = pg8::cvt_pk_bf16(st[kt][8 * s2 + 6], st[kt][8 * s2 + 7]);
                             u32x4 ww = {w0, w1, w2, w3}; pb = __builtin_bit_cast(bf16x8, ww); }
#pragma unroll
                for (int dt = 0; dt < 2; ++dt) {
                    const s16x4 lo = vtr(lds + vrd + dt * 24576 + (kt * 32 + s2 * 16) * 64), hi = vtr(lds + vrd + dt * 24576 + (kt * 32 + s2 * 16 + 8) * 64);
                    bf16x8 av; av[0] = lo[0]; av[1] = lo[1]; av[2] = lo[2]; av[3] = lo[3]; av[4] = hi[0]; av[5] = hi[1]; av[6] = hi[2]; av[7] = hi[3];
                    if (dt == 0) o0 = __builtin_amdgcn_mfma_f32_32x32x16_bf16(av, pb, o0, 0, 0, 0); else o1 = __builtin_amdgcn_mfma_f32_32x32x16_bf16(av, pb, o1, 0, 0, 0);
                }
            }
        const float inv = 1.0f / sum; const size_t tok = t.rowbase + (size_t)(l0 + i32) * t.d + t.r;
        bf16_t* op = opart + ((size_t)t.pat * MT + tok) * AW + t.h * 64 + 16 * hh;
#pragma unroll
        for (int hv = 0; hv < 2; ++hv) {
            u32x4 w; w.x = pg8::cvt_pk_bf16(o0[8 * hv] * inv, o0[8 * hv + 1] * inv); w.y = pg8::cvt_pk_bf16(o0[8 * hv + 2] * inv, o0[8 * hv + 3] * inv);
            w.z = pg8::cvt_pk_bf16(o0[8 * hv + 4] * inv, o0[8 * hv + 5] * inv); w.w = pg8::cvt_pk_bf16(o0[8 * hv + 6] * inv, o0[8 * hv + 7] * inv); *(u32x4*)(op + 8 * hv) = w;
            u32x4 w2; w2.x = pg8::cvt_pk_bf16(o1[8 * hv] * inv, o1[8 * hv + 1] * inv); w2.y = pg8::cvt_pk_bf16(o1[8 * hv + 2] * inv, o1[8 * hv + 3] * inv);
            w2.z = pg8::cvt_pk_bf16(o1[8 * hv + 4] * inv, o1[8 * hv + 5] * inv); w2.w = pg8::cvt_pk_bf16(o1[8 * hv + 6] * inv, o1[8 * hv + 7] * inv); *(u32x4*)(op + 32 + 8 * hv) = w2;
        }
        if (hh == 0) *(f32x2*)(ml + (((size_t)t.pat * MT + tok) * 16 + t.h) * 2) = (f32x2){mx * 0.125f, sum};
        __syncthreads();
    }
#undef AT_ISSUE
}

__device__ __forceinline__ void combine_row(const bf16_t* opart, const float* ml, const bf16_t* yb, const float* ga, const float* gb, bf16_t* Y, size_t row, int lane) {
    const int head = lane >> 2;
    float m[3], l[3];
#pragma unroll
    for (int p = 0; p < 3; ++p) { const f32x2 v = *(const f32x2*)(ml + (((size_t)p * MT + row) * 16 + head) * 2); m[p] = v[0]; l[p] = v[1]; }
    const float mg = fmaxf(m[0], fmaxf(m[1], m[2]));
    float w[3], den = 0.f;
#pragma unroll
    for (int p = 0; p < 3; ++p) { w[p] = __expf(m[p] - mg) * l[p]; den += w[p]; }
    const float iden = 1.0f / den;
    float ya[16];
#pragma unroll
    for (int e = 0; e < 16; ++e) ya[e] = 0.f;
#pragma unroll
    for (int p = 0; p < 3; ++p) { const u32x4* src = (const u32x4*)(opart + ((size_t)p * MT + row) * AW + lane * 16); const float wp = w[p] * iden;
#pragma unroll
        for (int hv = 0; hv < 2; ++hv) { const u32x4 x = src[hv];
            ya[8 * hv + 0] += wp * bflo(x.x); ya[8 * hv + 1] += wp * bfhi(x.x); ya[8 * hv + 2] += wp * bflo(x.y); ya[8 * hv + 3] += wp * bfhi(x.y);
            ya[8 * hv + 4] += wp * bflo(x.z); ya[8 * hv + 5] += wp * bfhi(x.z); ya[8 * hv + 6] += wp * bflo(x.w); ya[8 * hv + 7] += wp * bfhi(x.w); } }
    float s = 0.f;
#pragma unroll
    for (int e = 0; e < 16; ++e) s += ya[e] * ya[e];
    float rstd = rsqrtf(wave_sum(s) * (1.f / AW) + EPS);
    {   u32x4 o[2];
#pragma unroll
        for (int hv = 0; hv < 2; ++hv) { const f32x4 g0 = *(const f32x4*)(ga + lane * 16 + 8 * hv), g1 = *(const f32x4*)(ga + lane * 16 + 8 * hv + 4);
            o[hv].x = pk2(ya[8 * hv] * rstd * g0[0], ya[8 * hv + 1] * rstd * g0[1]); o[hv].y = pk2(ya[8 * hv + 2] * rstd * g0[2], ya[8 * hv + 3] * rstd * g0[3]);
            o[hv].z = pk2(ya[8 * hv + 4] * rstd * g1[0], ya[8 * hv + 5] * rstd * g1[1]); o[hv].w = pk2(ya[8 * hv + 6] * rstd * g1[2], ya[8 * hv + 7] * rstd * g1[3]); }
        u32x4* dst = (u32x4*)(Y + row * DM + lane * 16); dst[0] = o[0]; dst[1] = o[1]; }
    float yv[16];
    { const u32x4* src = (const u32x4*)(yb + row * SW + lane * 16);
#pragma unroll
        for (int hv = 0; hv < 2; ++hv) { const u32x4 x = src[hv];
            yv[8 * hv + 0] = bflo(x.x); yv[8 * hv + 1] = bfhi(x.x); yv[8 * hv + 2] = bflo(x.y); yv[8 * hv + 3] = bfhi(x.y);
            yv[8 * hv + 4] = bflo(x.z); yv[8 * hv + 5] = bfhi(x.z); yv[8 * hv + 6] = bflo(x.w); yv[8 * hv + 7] = bfhi(x.w); } }
    s = 0.f;
#pragma unroll
    for (int e = 0; e < 16; ++e) s += yv[e] * yv[e];
    rstd = rsqrtf(wave_sum(s) * (1.f / SW) + EPS);
    {   u32x4 o[2];
#pragma unroll
        for (int hv = 0; hv < 2; ++hv) { const f32x4 g0 = *(const f32x4*)(gb + lane * 16 + 8 * hv), g1 = *(const f32x4*)(gb + lane * 16 + 8 * hv + 4);
            o[hv].x = pk2(yv[8 * hv] * rstd * g0[0], yv[8 * hv + 1] * rstd * g0[1]); o[hv].y = pk2(yv[8 * hv + 2] * rstd * g0[2], yv[8 * hv + 3] * rstd * g0[3]);
            o[hv].z = pk2(yv[8 * hv + 4] * rstd * g1[0], yv[8 * hv + 5] * rstd * g1[1]); o[hv].w = pk2(yv[8 * hv + 6] * rstd * g1[2], yv[8 * hv + 7] * rstd * g1[3]); }
        u32x4* dst = (u32x4*)(Y + row * DM + AW + lane * 16); dst[0] = o[0]; dst[1] = o[1]; }
}

__global__ void __launch_bounds__(512, 2) fwd_mega(Args a) {
    extern __shared__ __attribute__((aligned(16))) unsigned char lds_raw[];
    LAS unsigned char* lds = (LAS unsigned char*)lds_raw;
    cg::grid_group grid = cg::this_grid();
    const int tid = threadIdx.x, lane = tid & 63, wave = __builtin_amdgcn_readfirstlane(tid >> 6);
    const int G = gridDim.x, bx = blockIdx.x;
    const int gw = bx * 8 + wave, NGW = G * 8;
    unsigned char* ws = a.ws;
    bf16_t* H4 = (bf16_t*)(ws + WS_BIG);
    bf16_t* U = (bf16_t*)(ws + WS_U);
    float* ss_mix = (float*)(ws + WS_SS), *ss_f2 = ss_mix + MT, *ss_ple = ss_f2 + MT;
    volatile LAS unsigned* bst = (volatile LAS unsigned*)(lds + LDS_BYTES - 64);
    if (tid < 2) bst[tid] = 0u;
    if (bx == 0) for (int i = tid; i < XCD_BAR_WORDS; i += 512) __hip_atomic_store((unsigned*)(ws + WS_BAR) + i, 0u, __ATOMIC_RELAXED, __HIP_MEMORY_SCOPE_AGENT);

    for (int i = bx * 512 + tid; i < 3 * MT; i += G * 512) ss_mix[i] = 0.f;
    for (int g_ = bx; g_ < SG; g_ += G) ssm_precompute(a, g_, lds, tid);
    {
        LAS float* scr = (LAS float*)(lds + wave * 16640);
        transpose_set<0>(a, scr, gw, NGW, lane);
        if (G != 256) transpose_set<1>(a, scr, gw, NGW, lane);
        { const f32x4* src = (const f32x4*)a.in[I_P]; u32x2* dst = (u32x2*)(ws + WS_PBF); const size_t n4 = (size_t)MT * PLE / 4;
          for (size_t i = (size_t)bx * 512 + tid; i < n4; i += (size_t)G * 512) { const f32x4 v = src[i]; u32x2 w; w.x = pk2(v[0], v[1]); w.y = pk2(v[2], v[3]); dst[i] = w; } }
        for (int m = gw; m < MT; m += 2 * NGW) rms_row2_bf16(a.in[I_X] + (size_t)m * DM, a.in[I_X] + (size_t)(m + NGW) * DM, a.in[I_F1N], U + (size_t)m * DM, U + (size_t)(m + NGW) * DM, lane);
    }
    grid.sync();
    const XcdBarrier bar = xcd_barrier_post((unsigned*)(ws + WS_BAR), bst);
#define SEAM() xcd_barrier(bar)

    pg8::StaticOrder S;
    { pg8::Gemm g{U, (const bf16_t*)(ws + WS_GU1), DM, DM, DM}; S.init(MT / 256, NGU / 256, G, bx, 0);
      pg8::EpiSwiGLU E{(bf16_t*)(ws + WS_HID), nullptr}; pg8::gemm_phase(lds, g, S, E); }
    if (G == 256 && bx >= 128) {
        transpose_set<1>(a, (LAS float*)(lds + wave * 16640), (bx - 128) * 8 + wave, 1024, lane); __syncthreads(); }
    SEAM();
    { pg8::Gemm g{(const bf16_t*)(ws + WS_HID), (const bf16_t*)(ws + WS_DN1), FF, FF, FF}; S.init(MT / 256, DM / 256, G, bx, 0, 4);
      pg8::EpiResid<true> E{a.in[I_X], U, ss_mix, 0.5f}; pg8::gemm_phase(lds, g, S, E); }
    SEAM();
    { pg8::Gemm g{U, (const bf16_t*)(ws + WS_WIN), DM, DM, DM}; S.init(MT / 256, NIN / 256, G, bx, 0);
      pg8::EpiWin E{(bf16_t*)(ws + WS_QKV), (bf16_t*)(ws + WS_ASSM), ss_mix}; pg8::gemm_phase(lds, g, S, E); }
    SEAM();
    { pg8::Gemm g{(const bf16_t*)(ws + WS_ASSM), (const bf16_t*)(ws + WS_EB), KT, 256, 256}; S.init(SG * ROWS_G / 256, 1, G, bx, ROWS_G / 256);
      pg8::EpiE E{(float*)(ws + WS_E)}; pg8::gemm_phase(lds, g, S, E); }
    __syncthreads();
    attn_phase((const bf16_t*)(ws + WS_QKV), (bf16_t*)(ws + WS_OP), (float*)(ws + WS_ML), lds, wave, lane, G);
    SEAM();
    if (wave == 0) for (int gb = bx; gb < SG * 4; gb += G) {
        const int g = gb >> 2, b = gb & 3, p = lane;
        const float2 a16 = ((const float2*)(ws + WS_A16))[g * 64 + p];
        const float* Eb = (const float*)(ws + WS_E) + ((size_t)g * ROWS_G + b * NCH) * 128;
        bf16_t* As = (bf16_t*)(ws + WS_ASSM) + ((size_t)g * ROWS_G + b * NCH) * KT + 256;
        float hr = 0.f, hi = 0.f;
        for (int c0 = 0; c0 < NCH; c0 += 16) {
            float er[16], ei[16];
#pragma unroll
            for (int j = 0; j < 16; ++j) { er[j] = Eb[(size_t)(c0 + j) * 128 + p]; ei[j] = Eb[(size_t)(c0 + j) * 128 + 64 + p]; }
#pragma unroll
            for (int j = 0; j < 16; ++j) { As[(size_t)(c0 + j) * KT + p] = (bf16_t)f2bf(hr); As[(size_t)(c0 + j) * KT + 64 + p] = (bf16_t)f2bf(hi);
                const float nr = a16.x * hr - a16.y * hi + er[j], ni = a16.x * hi + a16.y * hr + ei[j]; hr = nr; hi = ni; }
        }
    }
    SEAM();
    { pg8::Gemm g{(const bf16_t*)(ws + WS_ASSM), (const bf16_t*)(ws + WS_TG), KT, KT, KT}; S.init(SG * ROWS_G / 256, 1, G, bx, ROWS_G / 256);
      pg8::EpiToep E{(bf16_t*)(ws + WS_E)}; pg8::gemm_phase(lds, g, S, E); }
    SEAM();
    { pg8::Gemm g{(const bf16_t*)(ws + WS_E), (const bf16_t*)(ws + WS_WGLU), SW, SW, SW}; S.init(MT / 256, SW / 256, G, bx, 0);
      pg8::EpiGLU E{(const bf16_t*)(ws + WS_E), a.in[I_BGLU], (bf16_t*)(ws + WS_ASSM)}; pg8::gemm_phase(lds, g, S, E); }
    SEAM();
    for (int m = gw; m < MT; m += NGW) combine_row((const bf16_t*)(ws + WS_OP), (const float*)(ws + WS_ML), (const bf16_t*)(ws + WS_ASSM), a.in[I_AON], a.in[I_SON], (bf16_t*)(ws + WS_Y), (size_t)m, lane);
    SEAM();
    { pg8::Gemm g{(const bf16_t*)(ws + WS_Y), (const bf16_t*)(ws + WS_WOUT), DM, DM, DM}; S.init(MT / 256, DM / 256, G, bx, 0, 4);
      pg8::EpiResid<false> E{nullptr, U, ss_f2, 1.0f}; pg8::gemm_phase(lds, g, S, E); }
    SEAM();
    { pg8::Gemm g{U, (const bf16_t*)(ws + WS_GU2), DM, DM, DM}; S.init(MT / 256, NGU / 256, G, bx, 0);
      pg8::EpiSwiGLU E{(bf16_t*)(ws + WS_HID), ss_f2}; pg8::gemm_phase(lds, g, S, E); }
    {
      const bool tail_fill = (G == 256); pg8::Gemm g{(const bf16_t*)(ws + WS_PBF), (const bf16_t*)(ws + WS_WPLE), PLE, PLE, PLE};
      if (tail_fill) S.init(MT / 256, DM / 256, 128, bx - 128, 0); else S.init(MT / 256, DM / 256, G, bx, 0, 4);
      pg8::EpiBf16 E{(bf16_t*)(ws + WS_PP), DM}; if (!tail_fill || bx >= 128) pg8::gemm_phase(lds, g, S, E); }
    SEAM();
    { pg8::Gemm g{(const bf16_t*)(ws + WS_HID), (const bf16_t*)(ws + WS_DN2), FF, FF, FF}; S.init(MT / 256, DM / 256, G, bx, 0, 4);
      pg8::EpiResid<false> E{nullptr, U, ss_ple, 0.5f}; pg8::gemm_phase(lds, g, S, E); }
    SEAM();
    { pg8::Gemm g{U, (const bf16_t*)(ws + WS_WPG), DM, DM, DM}; S.init(MT / 256, DM / 256, G, bx, 0, 4);
      pg8::EpiPleGate E{H4, U, (const bf16_t*)(ws + WS_PP), ss_ple}; pg8::gemm_phase(lds, g, S, E); }
    SEAM();
    for (int m = gw; m < MT; m += 2 * NGW) rms_row2_out(H4 + (size_t)m * DM, H4 + (size_t)(m + NGW) * DM, a.out + (size_t)m * DM, a.out + (size_t)(m + NGW) * DM, a.in[I_FINN], lane);
}

extern "C" void kernel_launch(void* const* d_in, const int* in_sizes, int n_in, void* d_out, int out_size, void* d_ws, size_t ws_size, hipStream_t stream) {
    static int grid = 0;
    if (grid == 0) {
        if (n_in != 29 || out_size != MT * DM || ws_size < WS_END) { fprintf(stderr, "kernel_launch: unexpected problem (n_in %d out %d ws %zu need %zu)\n", n_in, out_size, ws_size, (size_t)WS_END); grid = -1; return; }
        int dev = 0, cus = 0, per_cu = 0;
        (void)hipGetDevice(&dev);
        (void)hipDeviceGetAttribute(&cus, hipDeviceAttributeMultiprocessorCount, dev);
        (void)hipFuncSetAttribute((const void*)fwd_mega, hipFuncAttributeMaxDynamicSharedMemorySize, LDS_BYTES);
        (void)hipOccupancyMaxActiveBlocksPerMultiprocessor(&per_cu, (const void*)fwd_mega, 512, LDS_BYTES);
        (void)hipGetLastError();
        grid = cus;
        fprintf(stderr, "kernel_launch: cus %d per_cu %d grid %d ws %zu need %zu\n", cus, per_cu, grid, ws_size, (size_t)WS_END);
    }
    if (grid < 0) return;
    Args a{};
    for (int i = 0; i < 29; ++i) a.in[i] = (const float*)d_in[i];
    a.out = (float*)d_out; a.ws = (unsigned char*)d_ws;
    void* args[] = {&a};
    hipError_t e = hipLaunchCooperativeKernel((const void*)fwd_mega, dim3(grid), dim3(512), args, LDS_BYTES, stream);
    if (e != hipSuccess) fprintf(stderr, "kernel_launch: cooperative launch failed: %s\n", hipGetErrorString(e));
}
```
